# Optimizing an MI355X kernel written in HIP

```python
import jax, jax.numpy as jnp
from jax import lax
import numpy as np

D_MODEL = 1024
BATCH = 2
SEQ = 8192
DEPTH = 1

HEAD_DIM = 64
N_FOX_HEADS = 8
N_SB_HEADS = 8
FOX_WIDTH = N_FOX_HEADS * HEAD_DIM
SB_WIDTH = N_SB_HEADS * HEAD_DIM
MIX_WIDTH = FOX_WIDTH + SB_WIDTH
IN_COLS = 3 * FOX_WIDTH + 3 * SB_WIDTH + N_FOX_HEADS
Q_BLOCK = 128
N_MEM = 256
N_MEM_HEADS = 4
MEM_HEAD_DIM = D_MODEL // N_MEM_HEADS
D_FF = ((8 * D_MODEL // 3 + 255) // 256) * 256
CONV_WIDTH = 3
EPS = 1e-6

kernel_name = "hybrid_fox_stickbreak_memxattn_convffn"


def _rmsnorm(x, g):
    xf = x.astype(jnp.float32)
    y = xf * lax.rsqrt(jnp.mean(xf * xf, axis=-1, keepdims=True) + EPS)
    return (y * g.astype(jnp.float32)).astype(x.dtype)


def _heads(t, n):
    b, s, w = t.shape
    return t.reshape(b, s, n, w // n).transpose(0, 2, 1, 3)


def _merge(t):
    b, n, s, d = t.shape
    return t.transpose(0, 2, 1, 3).reshape(b, s, n * d)


def _sweep(fn, q, *per_query):
    b, h, s, d = q.shape
    n = s // Q_BLOCK
    qb = q.reshape(b, h, n, Q_BLOCK, d).transpose(2, 0, 1, 3, 4)
    extras = [e.reshape(b, h, n, Q_BLOCK).transpose(2, 0, 1, 3) for e in per_query]
    out = lax.map(lambda a: fn(*a), (jnp.arange(n), qb, *extras))
    return out.transpose(1, 2, 0, 3, 4).reshape(b, h, s, d)


def _fox_attention(q, k, v, log_f):
    s_len = q.shape[2]
    scale = HEAD_DIM ** -0.5
    c = jnp.cumsum(log_f.astype(jnp.float32), axis=-1)
    kpos = jnp.arange(s_len)

    def block(i, qi, ci):
        qpos = i * Q_BLOCK + jnp.arange(Q_BLOCK)
        logits = jnp.einsum('bhqd,bhkd->bhqk', qi, k, preferred_element_type=jnp.float32) * scale
        logits = logits + ci[..., None] - c[:, :, None, :]
        logits = jnp.where(kpos[None, :] <= qpos[:, None], logits, -jnp.inf)
        p = jax.nn.softmax(logits, axis=-1)
        return jnp.einsum('bhqk,bhkd->bhqd', p.astype(v.dtype), v)

    return _sweep(block, q, c)


def _stick_breaking_attention(q, k, v):
    s_len = q.shape[2]
    scale = HEAD_DIM ** -0.5
    kpos = jnp.arange(s_len)

    def block(i, qi):
        qpos = i * Q_BLOCK + jnp.arange(Q_BLOCK)
        z = jnp.einsum('bhqd,bhkd->bhqk', qi, k, preferred_element_type=jnp.float32) * scale
        strict = kpos[None, :] < qpos[:, None]
        log_keep = jnp.where(strict, jax.nn.log_sigmoid(-z), 0.0)
        after = lax.cumsum(log_keep, axis=3, reverse=True) - log_keep
        a = jnp.where(strict, jnp.exp(jax.nn.log_sigmoid(z) + after), 0.0)
        return jnp.einsum('bhqk,bhkd->bhqd', a.astype(v.dtype), v)

    return _sweep(block, q)


def _memory_cross_attention(h, m, w_q, w_kv, w_o):
    q = _heads(jnp.einsum('bsd,dc->bsc', h, w_q), N_MEM_HEADS)
    kv = jnp.einsum('bmd,dc->bmc', m, w_kv)
    k, v = jnp.split(kv, 2, axis=-1)
    k, v = _heads(k, N_MEM_HEADS), _heads(v, N_MEM_HEADS)
    logits = jnp.einsum('bhqd,bhkd->bhqk', q, k, preferred_element_type=jnp.float32) * (MEM_HEAD_DIM ** -0.5)
    p = jax.nn.softmax(logits, axis=-1)
    o = jnp.einsum('bhqk,bhkd->bhqd', p.astype(v.dtype), v)
    return jnp.einsum('bsc,cd->bsd', _merge(o), w_o)


def _causal_dwconv(u, w, b):
    s_len = u.shape[1]
    up = jnp.pad(u, ((0, 0), (CONV_WIDTH - 1, 0), (0, 0)))
    y = b
    for i in range(CONV_WIDTH):
        y = y + up[:, i:i + s_len] * w[i]
    return y


def setup_inputs(seed: int = 0) -> dict:
    key = jax.random.key(seed)
    ks = jax.random.split(key, 24)
    f32 = jnp.float32

    def nrm(k, shape, fan_in):
        return jax.random.normal(k, shape, f32) * (fan_in ** -0.5)

    def gain(k, shape):
        return 1.0 + 0.02 * jax.random.normal(k, shape, f32)

    return {
        "x": jax.random.normal(ks[0], (BATCH, SEQ, D_MODEL), f32),
        "mem": jax.random.normal(ks[1], (BATCH, N_MEM, D_MODEL), f32),
        "attn_norm_g": gain(ks[2], (DEPTH, D_MODEL)),
        "w_in": nrm(ks[3], (DEPTH, D_MODEL, IN_COLS), D_MODEL),
        "b_forget": jnp.linspace(1.0, 6.0, N_FOX_HEADS, dtype=f32)[None, :]
                    + 0.1 * jax.random.normal(ks[4], (DEPTH, N_FOX_HEADS), f32),
        "fox_out_g": gain(ks[5], (DEPTH, FOX_WIDTH)),
        "sb_out_g": gain(ks[6], (DEPTH, SB_WIDTH)),
        "w_out": nrm(ks[7], (DEPTH, MIX_WIDTH, D_MODEL), MIX_WIDTH),
        "xattn_norm_g": gain(ks[8], (DEPTH, D_MODEL)),
        "mem_norm_g": gain(ks[9], (DEPTH, D_MODEL)),
        "w_mq": nrm(ks[10], (DEPTH, D_MODEL, D_MODEL), D_MODEL),
        "w_mkv": nrm(ks[11], (DEPTH, D_MODEL, 2 * D_MODEL), D_MODEL),
        "w_mo": nrm(ks[12], (DEPTH, D_MODEL, D_MODEL), D_MODEL),
        "ffn_norm_g": gain(ks[13], (DEPTH, D_MODEL)),
        "w_up": nrm(ks[14], (DEPTH, D_MODEL, 2 * D_FF), D_MODEL),
        "conv_w": nrm(ks[15], (DEPTH, CONV_WIDTH, 2 * D_FF), CONV_WIDTH),
        "conv_b": 0.02 * jax.random.normal(ks[16], (DEPTH, 2 * D_FF), f32),
        "w_down": nrm(ks[17], (DEPTH, D_FF, D_MODEL), D_FF),
        "final_norm_g": gain(ks[18], (D_MODEL,)),
    }


def reference(x, mem, attn_norm_g, w_in, b_forget, fox_out_g, sb_out_g, w_out,
              xattn_norm_g, mem_norm_g, w_mq, w_mkv, w_mo,
              ffn_norm_g, w_up, conv_w, conv_b, w_down, final_norm_g):
    split_at = np.cumsum([FOX_WIDTH, FOX_WIDTH, FOX_WIDTH, SB_WIDTH, SB_WIDTH, SB_WIDTH]).tolist()
    for l in range(DEPTH):
        h = _rmsnorm(x, attn_norm_g[l])
        proj = jnp.einsum('bsd,dc->bsc', h, w_in[l])
        fq, fk, fv, sq, sk, sv, f_logit = jnp.split(proj, split_at, axis=-1)
        log_f = jax.nn.log_sigmoid(f_logit.astype(jnp.float32) + b_forget[l].astype(jnp.float32))
        log_f = log_f.transpose(0, 2, 1)
        fox_o = _merge(_fox_attention(_heads(fq, N_FOX_HEADS), _heads(fk, N_FOX_HEADS),
                                      _heads(fv, N_FOX_HEADS), log_f))
        sb_o = _merge(_stick_breaking_attention(_heads(sq, N_SB_HEADS), _heads(sk, N_SB_HEADS),
                                                _heads(sv, N_SB_HEADS)))
        mixed = jnp.concatenate([_rmsnorm(fox_o, fox_out_g[l]), _rmsnorm(sb_o, sb_out_g[l])], axis=-1)
        x = x + jnp.einsum('bsc,cd->bsd', mixed, w_out[l])

        h = _rmsnorm(x, xattn_norm_g[l])
        m = _rmsnorm(mem, mem_norm_g[l])
        x = x + _memory_cross_attention(h, m, w_mq[l], w_mkv[l], w_mo[l])

        h = _rmsnorm(x, ffn_norm_g[l])
        u = jnp.einsum('bsd,df->bsf', h, w_up[l])
        u = _causal_dwconv(u, conv_w[l], conv_b[l])
        gate, val = jnp.split(u, 2, axis=-1)
        x = x + jnp.einsum('bsf,fd->bsd', jax.nn.silu(gate) * val, w_down[l])
    return _rmsnorm(x, final_norm_g)
```

```cpp
#include <hip/hip_runtime.h>
#include <hip/hip_cooperative_groups.h>
#include <cstdio>
#include <cstdint>
namespace cg = cooperative_groups;
namespace pg8 {
#define PG8_LAS __attribute__((address_space(3)))
typedef unsigned short bf16_t;
typedef short bf16x8 __attribute__((ext_vector_type(8)));
typedef float f32x4 __attribute__((ext_vector_type(4)));
typedef unsigned u32x4 __attribute__((ext_vector_type(4)));
constexpr int BM = 256, BK = 64, HALF = 128, HTB = HALF * BK * 2  , STAGE_BYTES = 8 * HTB, NXCD = 8, WGM = 8;

__host__ __device__ __forceinline__ int lds_byte(int r, int c) { const int st = (r >> 4) * 2 + (c >> 5), rr = r & 15, cc = c & 31, ob = rr * 64 + cc * 2; return st * 1024 + (ob ^ (((ob >> 9) & 1) << 5)); }
__host__ __device__ __forceinline__ void stage_rc(int b, int& R, int& C) { const int st = b / 1024, sb = b % 1024, swz = sb ^ (((sb >> 9) & 1) << 5); R = (st >> 1) * 16 + swz / 64; C = (st & 1) * 32 + (swz % 64) / 2; }
__host__ __device__ __forceinline__ int perm32(int rho) { const int n = rho >> 4, i = rho & 15; return 8 * (i >> 2) + 4 * n + (i & 3); }

struct Unit { int pm, pn; };
struct Gemm { const bf16_t* A; const bf16_t* Bt; int M, N, K, lda, ldb; };

struct StaticOrder {
    int nM, nN, nwg, G, c;
    __host__ __device__ void init(int M, int N, int G_, int c_) { nM = M / BM; nN = N / BM; nwg = nM * nN; G = G_; c = c_; }
    __host__ __device__ bool next(int i, Unit& u) const {
        const long L = (long)i * G + c; if (L >= nwg) return false;
        int wgid = (int)L; { const int q = nwg / NXCD, r = nwg % NXCD, xcd = wgid % NXCD, off = wgid / NXCD; wgid = (xcd < r ? xcd * (q + 1) : r * (q + 1) + (xcd - r) * q) + off; }
        const int nig = WGM * nN, gid = wgid / nig, fm = gid * WGM, gsz = (nM - fm) < WGM ? (nM - fm) : WGM;
        u.pm = fm + ((wgid % nig) % gsz); u.pn = (wgid % nig) / gsz; return true;
    }
    __device__ __forceinline__ void a_ready(const Unit&) const {}
    __device__ __forceinline__ void done(const Unit&) const {}
};

__device__ __forceinline__ unsigned cvt_pk_bf16(float lo, float hi) { unsigned r; asm volatile("v_cvt_pk_bf16_f32 %0, %1, %2" : "=v"(r) : "v"(lo), "v"(hi)); return r; }
typedef float f32x2 __attribute__((ext_vector_type(2)));
__device__ __forceinline__ f32x2 gelu_pk(f32x2 v) {
    const f32x2 av = __builtin_elementwise_abs(v), d = av * 0.2316418882f + 1.0f;
    f32x2 t; t.x = __builtin_amdgcn_rcpf(d.x); t.y = __builtin_amdgcn_rcpf(d.y);
    f32x2 q = t * 0.5307027145f + (-0.7265760135f); q = q * t + 0.7107068705f; q = q * t + (-0.142248368f); q = q * t + 0.127414796f; q = q * t;
    const f32x2 s = (v * v) * (-0.72134752044f);
    f32x2 e; e.x = __builtin_amdgcn_exp2f(s.x); e.y = __builtin_amdgcn_exp2f(s.y);
    const f32x2 m = v * (q * e), r = v - m;
    f32x2 o; o.x = v.x < 0.f ? m.x : r.x; o.y = v.y < 0.f ? m.y : r.y; return o;
}

template <int ACT  > struct EpiBf16 {
    static constexpr bool PERM = true, AFTER_DRAIN = false; static_assert(ACT == 0 || ACT == 1, "EpiBf16: ACT is 0 (none) or 1 (gelu_pk)");
    bf16_t* O; int ldc; const float* bias; int split_cols; size_t split_stride; float scale0;
    __device__ __forceinline__ void operator()(const f32x4 (&acc)[2][2][4][2], const Unit& u, int wr, int wc, int fr, int fq) const {
        const int row0 = u.pm * BM + wr * 64 + fr; int colt = u.pn * BM; bf16_t* base = O;
        float sc = 1.f; if (split_cols) { const int t = colt / split_cols; base += (size_t)t * split_stride; colt -= t * split_cols; if (t == 0) sc = scale0; }
        const int col0 = colt + wc * 32 + 8 * fq, bcol0 = u.pn * BM + wc * 32 + 8 * fq;
        f32x4 bv[2][2];
#pragma unroll
        for (int bj = 0; bj < 2; ++bj)
#pragma unroll
            for (int n = 0; n < 2; ++n) bv[bj][n] = bias ? *(const f32x4*)(bias + bcol0 + bj * HALF + 4 * n) : (f32x4){0.f, 0.f, 0.f, 0.f};
#pragma unroll
        for (int ai = 0; ai < 2; ++ai)
#pragma unroll
            for (int m = 0; m < 4; ++m) { bf16_t* rowp = base + (size_t)(row0 + ai * HALF + m * 16) * ldc + col0;
#pragma unroll
                for (int bj = 0; bj < 2; ++bj) { f32x4 v0 = acc[ai][bj][m][0] + bv[bj][0], v1 = acc[ai][bj][m][1] + bv[bj][1];
                    if (ACT == 1) { f32x2 a = gelu_pk((f32x2){v0[0], v0[1]}), b = gelu_pk((f32x2){v0[2], v0[3]}), c = gelu_pk((f32x2){v1[0], v1[1]}), d = gelu_pk((f32x2){v1[2], v1[3]});
                        v0 = (f32x4){a.x, a.y, b.x, b.y}; v1 = (f32x4){c.x, c.y, d.x, d.y}; }
                    v0 = v0 * sc; v1 = v1 * sc; u32x4 w; w.x = cvt_pk_bf16(v0[0], v0[1]); w.y = cvt_pk_bf16(v0[2], v0[3]); w.z = cvt_pk_bf16(v1[0], v1[1]); w.w = cvt_pk_bf16(v1[2], v1[3]);
                    *(u32x4*)(rowp + bj * HALF) = w; } }
    }
};
struct EpiResF32 {
    static constexpr bool PERM = false, AFTER_DRAIN = false;
    const float* base; float* out; int ldc;
    __device__ __forceinline__ void operator()(const f32x4 (&acc)[2][2][4][2], const Unit& u, int wr, int wc, int fr, int fq) const {
        const int col0 = u.pn * BM + wc * 32 + 4 * fq;
#pragma unroll
        for (int ai = 0; ai < 2; ++ai)
#pragma unroll
            for (int m = 0; m < 4; ++m) { const size_t off = (size_t)(u.pm * BM + ai * HALF + wr * 64 + m * 16 + fr) * ldc + col0;
#pragma unroll
                for (int bj = 0; bj < 2; ++bj)
#pragma unroll
                    for (int n = 0; n < 2; ++n) { f32x4 v = acc[ai][bj][m][n]; if (base) v += *(const f32x4*)(base + off + bj * HALF + n * 16); *(f32x4*)(out + off + bj * HALF + n * 16) = v; } }
    }
};
template <class Epi, class Sched, bool ALIGN_EPI = false, bool SP2 = false>
__device__ __forceinline__ void gemm_phase(PG8_LAS unsigned char* lds, const Gemm g, const Sched& S, const Epi& E) {
    int tid_ = threadIdx.x; asm volatile("" : "+v"(tid_));
    const int tid = tid_, wid = __builtin_amdgcn_readfirstlane(tid >> 6), lane = tid & 63, wr = wid >> 2, wc = wid & 3, fr = lane & 15, fq = lane >> 4;
    const int K = g.K, nt = K / BK;
    unsigned voffA[2], voffB[2];
#pragma unroll
    for (int i = 0; i < 2; ++i) { int R, C; stage_rc(tid * 16 + i * 8192, R, C); const int Rb = Epi::PERM ? ((R & ~31) + perm32(R & 31)) : R;
        voffA[i] = (unsigned)(R * g.lda + C) * 2u; voffB[i] = (unsigned)(Rb * g.ldb + C) * 2u; }
    const size_t kstep = (size_t)(BK * 2);
    const size_t hstepA = (size_t)HALF * g.lda * 2, hstepB = (size_t)HALF * g.ldb * 2;
    const size_t tstepA = 2 * hstepA, tstepB = 2 * hstepB;
    const unsigned ldsw = (unsigned)wid * 1024u;
    const int aoff = lds_byte(wr * 64 + fr, fq * 8), boff = lds_byte(wc * 32 + fr, fq * 8);
#define PG8_SA(b, h) (((b) * 2 + (h)) * HTB)
#define PG8_SB(b, h) ((4 + (b) * 2 + (h)) * HTB)
#define PG8_STAGE(bufoff, gbase, voff) do { _Pragma("unroll") for (int _i = 0; _i < 2; ++_i) \
        __builtin_amdgcn_global_load_lds((const unsigned*)((const char*)(gbase) + (voff)[_i]), (PG8_LAS unsigned*)(lds + (bufoff) + ldsw + _i * 8192), 16, 0, 0); } while (0)
#define PG8_LDA(dst, b, h) do { _Pragma("unroll") for (int m = 0; m < 4; ++m) _Pragma("unroll") for (int k = 0; k < 2; ++k) dst[m][k] = *(const PG8_LAS bf16x8*)(lds + PG8_SA(b, h) + aoff + m * 2048 + k * 1024); } while (0)
#define PG8_LDB(dst, b, h) do { _Pragma("unroll") for (int n = 0; n < 2; ++n) _Pragma("unroll") for (int k = 0; k < 2; ++k) dst[n][k] = *(const PG8_LAS bf16x8*)(lds + PG8_SB(b, h) + boff + n * 2048 + k * 1024); } while (0)
#define PG8_MMA(ai, bj, At, Bt) do { __builtin_amdgcn_s_setprio(1); _Pragma("unroll") for (int m = 0; m < 4; ++m) _Pragma("unroll") for (int n = 0; n < 2; ++n) _Pragma("unroll") for (int k = 0; k < 2; ++k) \
        acc[ai][bj][m][n] = __builtin_amdgcn_mfma_f32_16x16x32_bf16(Bt[n][k], At[m][k], acc[ai][bj][m][n], 0, 0, 0); __builtin_amdgcn_s_setprio(0); } while (0)
#define PG8_WAIT_V(n) asm volatile("s_waitcnt vmcnt(" #n ")" ::: "memory")
#define PG8_WAIT_L(n) asm volatile("s_waitcnt lgkmcnt(" #n ")" ::: "memory")
#define PG8_BAR __builtin_amdgcn_s_barrier()
#define PG8_SCHED __builtin_amdgcn_sched_barrier(0)
    Unit cur, nxt; int ui = 0;
    if (!S.next(0, cur)) return;
    f32x4 acc[2][2][4][2];
#pragma unroll
    for (int a = 0; a < 2; ++a)
#pragma unroll
        for (int b = 0; b < 2; ++b)
#pragma unroll
            for (int m = 0; m < 4; ++m)
#pragma unroll
                for (int n = 0; n < 2; ++n) acc[a][b][m][n] = (f32x4){0.f, 0.f, 0.f, 0.f};
    bf16x8 At[4][2], B0[2][2], B1[2][2];
    const char* cA = (const char*)g.A + (size_t)cur.pm * tstepA; const char* cB = (const char*)g.Bt + (size_t)cur.pn * tstepB;
    S.a_ready(cur);
    if constexpr (SP2) {
        PG8_STAGE(PG8_SB(0, 0), cB, voffB); PG8_STAGE(PG8_SB(0, 1), cB + hstepB, voffB); PG8_STAGE(PG8_SA(0, 0), cA, voffA); PG8_STAGE(PG8_SA(0, 1), cA + hstepA, voffA);
        if (wr == 1) PG8_BAR;
        PG8_WAIT_V(2); PG8_BAR;
        PG8_STAGE(PG8_SB(1, 0), cB + kstep, voffB); PG8_STAGE(PG8_SA(1, 0), cA + kstep, voffA); PG8_STAGE(PG8_SB(1, 1), cB + hstepB + kstep, voffB);
        PG8_WAIT_V(6); PG8_BAR;
    } else {
        PG8_STAGE(PG8_SB(0, 0), cB, voffB); PG8_STAGE(PG8_SA(0, 0), cA, voffA); PG8_STAGE(PG8_SB(0, 1), cB + hstepB, voffB); PG8_STAGE(PG8_SA(0, 1), cA + hstepA, voffA);
        if (wr == 1) PG8_BAR;
        PG8_WAIT_V(4); PG8_BAR;
        PG8_STAGE(PG8_SB(1, 0), cB + kstep, voffB); PG8_STAGE(PG8_SA(1, 0), cA + kstep, voffA); PG8_STAGE(PG8_SB(1, 1), cB + hstepB + kstep, voffB);
        PG8_WAIT_V(6); PG8_BAR;
    }
    for (;;) {
        const bool has_next = S.next(ui + 1, nxt);
        const char* nA = has_next ? (const char*)g.A + (size_t)nxt.pm * tstepA : cA; const char* nB = has_next ? (const char*)g.Bt + (size_t)nxt.pn * tstepB : cB;
        for (int t = 0; t < nt; t += 2) {
            const bool last = (t == nt - 2);
            const char* a1 = cA + (size_t)(t + 1) * kstep;
            const char* a2 = last ? nA : cA + (size_t)(t + 2) * kstep; const char* b2 = last ? nB : cB + (size_t)(t + 2) * kstep;
            const char* a3 = a2 + kstep; const char* b3 = b2 + kstep;
            if (last && has_next) S.a_ready(nxt);
            if constexpr (SP2) {
            PG8_LDB(B0, 0, 0); PG8_LDB(B1, 0, 1); PG8_SCHED; PG8_LDA(At, 0, 0); PG8_STAGE(PG8_SA(1, 1), a1 + hstepA, voffA);
            PG8_WAIT_V(8); PG8_WAIT_L(0); PG8_BAR; PG8_MMA(0, 0, At, B0); PG8_MMA(0, 1, At, B1); PG8_BAR; PG8_SCHED;
            PG8_LDA(At, 0, 1); PG8_STAGE(PG8_SB(0, 0), b2, voffB); PG8_STAGE(PG8_SB(0, 1), b2 + hstepB, voffB); PG8_STAGE(PG8_SA(0, 0), a2, voffA);
            PG8_WAIT_V(8); PG8_WAIT_L(0); PG8_BAR; PG8_MMA(1, 0, At, B0); PG8_MMA(1, 1, At, B1); PG8_BAR; PG8_SCHED;
            PG8_LDB(B0, 1, 0); PG8_LDB(B1, 1, 1); PG8_SCHED; PG8_LDA(At, 1, 0); PG8_STAGE(PG8_SA(0, 1), a2 + hstepA, voffA);
            PG8_WAIT_V(8); PG8_WAIT_L(0); PG8_BAR; PG8_MMA(0, 0, At, B0); PG8_MMA(0, 1, At, B1); PG8_BAR; PG8_SCHED;
            PG8_LDA(At, 1, 1); PG8_STAGE(PG8_SB(1, 0), b3, voffB); PG8_STAGE(PG8_SB(1, 1), b3 + hstepB, voffB); PG8_STAGE(PG8_SA(1, 0), a3, voffA);
            PG8_WAIT_V(8); PG8_WAIT_L(0); PG8_BAR; PG8_MMA(1, 0, At, B0); PG8_MMA(1, 1, At, B1); PG8_BAR; PG8_SCHED;
            } else {
            PG8_LDB(B0, 0, 0); PG8_SCHED; PG8_LDA(At, 0, 0); PG8_STAGE(PG8_SA(1, 1), a1 + hstepA, voffA);
            PG8_WAIT_L(8); PG8_BAR; PG8_WAIT_L(0); PG8_MMA(0, 0, At, B0); PG8_BAR; PG8_SCHED;
            PG8_LDB(B1, 0, 1); PG8_STAGE(PG8_SB(0, 0), b2, voffB);
            PG8_BAR; PG8_WAIT_L(0); PG8_MMA(0, 1, At, B1); PG8_BAR;
            PG8_LDA(At, 0, 1); PG8_STAGE(PG8_SA(0, 0), a2, voffA);
            PG8_BAR; PG8_WAIT_L(0); PG8_MMA(1, 0, At, B0); PG8_BAR; PG8_SCHED;
            PG8_STAGE(PG8_SB(0, 1), b2 + hstepB, voffB);
            PG8_WAIT_V(6); PG8_BAR; PG8_MMA(1, 1, At, B1); PG8_BAR;
            PG8_LDB(B0, 1, 0); PG8_SCHED; PG8_LDA(At, 1, 0); PG8_STAGE(PG8_SA(0, 1), a2 + hstepA, voffA);
            PG8_WAIT_L(8); PG8_BAR; PG8_WAIT_L(0); PG8_MMA(0, 0, At, B0); PG8_BAR; PG8_SCHED;
            PG8_LDB(B1, 1, 1); PG8_STAGE(PG8_SB(1, 0), b3, voffB);
            PG8_BAR; PG8_WAIT_L(0); PG8_MMA(0, 1, At, B1); PG8_BAR;
            PG8_LDA(At, 1, 1); PG8_STAGE(PG8_SA(1, 0), a3, voffA);
            PG8_BAR; PG8_WAIT_L(0); PG8_MMA(1, 0, At, B0); PG8_BAR; PG8_SCHED;
            PG8_STAGE(PG8_SB(1, 1), b3 + hstepB, voffB);
            PG8_WAIT_V(6); PG8_BAR; PG8_MMA(1, 1, At, B1); PG8_BAR;
            }
        }
        if constexpr (ALIGN_EPI) { if (wr == 0) PG8_BAR; }
        if constexpr (!Epi::AFTER_DRAIN) { E(acc, cur, wr, wc, fr, fq); S.done(cur); }
        if (!has_next) break;
#pragma unroll
        for (int a = 0; a < 2; ++a)
#pragma unroll
            for (int b = 0; b < 2; ++b)
#pragma unroll
                for (int m = 0; m < 4; ++m)
#pragma unroll
                    for (int n = 0; n < 2; ++n) acc[a][b][m][n] = (f32x4){0.f, 0.f, 0.f, 0.f};
        cur = nxt; cA = nA; cB = nB; ++ui;
        if constexpr (ALIGN_EPI) { if (wr == 1) PG8_BAR; }
    }
    PG8_WAIT_V(0);
    if constexpr (!ALIGN_EPI) { if (wr == 0) PG8_BAR; }
    PG8_BAR;
    if constexpr (Epi::AFTER_DRAIN) { E.fused(acc, cur, wr, wc, fr, fq, lds, wid, lane); S.done(cur); }
#undef PG8_SA
#undef PG8_SB
#undef PG8_STAGE
#undef PG8_LDA
#undef PG8_LDB
#undef PG8_MMA
#undef PG8_WAIT_V
#undef PG8_WAIT_L
#undef PG8_BAR
#undef PG8_SCHED
}
}
#ifndef PG8_SP2
#define PG8_SP2 true
#endif
#ifndef PG8_ALIGN
#define PG8_ALIGN true
#endif
#define LAS __attribute__((address_space(3)))
typedef unsigned short bf16;
typedef unsigned v4u __attribute__((ext_vector_type(4)));
typedef unsigned v2u __attribute__((ext_vector_type(2)));
typedef float f32x4 __attribute__((ext_vector_type(4)));
typedef short bf16x8 __attribute__((ext_vector_type(8)));

constexpr int NWAVES = 8;
constexpr int BATCH = 2, SEQ = 8192, DM = 1024, M = BATCH * SEQ, NMEM = 256, DFF = 2816, HFF = DFF / 2  , INC = 3080;
constexpr float LOG2E = 1.4426950408889634f;
constexpr float EPS = 1e-6f;

__device__ __forceinline__ unsigned f2bf(float f) { unsigned u = __builtin_bit_cast(unsigned, f); return (u + 0x7fffu + ((u >> 16) & 1u)) >> 16; }
__device__ __forceinline__ unsigned pk2(float lo, float hi) { return f2bf(lo) | (f2bf(hi) << 16); }
__device__ __forceinline__ float bflo(unsigned w) { return __builtin_bit_cast(float, w << 16); }
__device__ __forceinline__ float bfhi(unsigned w) { return __builtin_bit_cast(float, w & 0xffff0000u); }
__device__ __forceinline__ float wave_sum(float v) {
#pragma unroll
    for (int o = 1; o < 64; o <<= 1) v += __shfl_xor(v, o);
    return v;
}
__device__ __forceinline__ float wave_max(float v) {
#pragma unroll
    for (int o = 1; o < 64; o <<= 1) v = fmaxf(v, __shfl_xor(v, o));
    return v;
}

namespace att {
typedef short s16x4 __attribute__((ext_vector_type(4)));
typedef float f32x16 __attribute__((ext_vector_type(16)));
typedef float f32x2_t __attribute__((ext_vector_type(2)));
typedef __bf16 bf16x2_t __attribute__((ext_vector_type(2)));
constexpr int KP = 144, VP = 144;
constexpr int OFF_K = 0, OFF_V = 2 * 64 * KP, OFF_C = OFF_V + 2 * 64 * VP, OFF_F = OFF_C + 512, LDS_BYTES = OFF_F + 64;
constexpr int QKLD = 2048, VTLD = 16384;
__device__ __forceinline__ unsigned cvtpk(float lo, float hi) { f32x2_t v = {lo, hi}; bf16x2_t b = __builtin_convertvector(v, bf16x2_t); return __builtin_bit_cast(unsigned, b); }
__device__ __forceinline__ float ex2(float x) { return __builtin_amdgcn_exp2f(x); }
__device__ __forceinline__ float lg2(float x) { return __builtin_amdgcn_logf(x); }

template <int MODE>
__device__ __forceinline__ void unit(int b, int h, int qb, const bf16* __restrict__ QK, const bf16* __restrict__ VT, const float* __restrict__ C2, bf16* __restrict__ AO, LAS unsigned char* lds) {
    int tid_ = threadIdx.x; asm volatile("" : "+v"(tid_));
    const int tid = tid_, lane = tid & 63, w = __builtin_amdgcn_readfirstlane(tid >> 6), r32 = lane & 31, hi = lane >> 5;
    const int q0 = qb * 256; const size_t rowbase = (size_t)b * SEQ;
    const bf16* Qp = QK + (rowbase + q0 + w * 32 + r32) * QKLD + MODE * 1024 + h * 64;
    const bf16* Kg = QK + rowbase * QKLD + MODE * 1024 + 512 + h * 64;
    const bf16* Vg = VT + (size_t)(MODE * 512 + h * 64) * VTLD + rowbase;
    const float* Cg = C2 + (size_t)(b * 8 + h) * SEQ;
    bf16x8 qr[4];
#pragma unroll
    for (int d0 = 0; d0 < 4; ++d0) qr[d0] = *(const bf16x8*)(Qp + d0 * 16 + hi * 8);
    const int srow = tid >> 3, sch = tid & 7;
    const bf16* kst = Kg + (size_t)srow * QKLD + sch * 8;
    const bf16* vst = Vg + (size_t)srow * VTLD + sch * 8;
    const int NT = 4 * qb + 4, tw = 4 * qb + (w >> 1);
    const int qq = 32 * (w & 1) + r32;
    v4u kreg, vreg; f32x4 creg = {0.f, 0.f, 0.f, 0.f};
    { const int t = NT - 1; kreg = *(const v4u*)(kst + (size_t)t * 64 * QKLD); vreg = *(const v4u*)(vst + t * 64); if (MODE == 0 && tid < 16) creg = *(const f32x4*)(Cg + t * 64 + tid * 4); }
    float cq = 0.f; if (MODE == 0) cq = Cg[q0 + w * 32 + r32];
    float mrun = -1e30f, lsum = 0.f, R = 0.f;
    f32x16 o0, o1;
#pragma unroll
    for (int r = 0; r < 16; ++r) { o0[r] = 0.f; o1[r] = 0.f; }
    LAS unsigned* flags = (LAS unsigned*)(lds + OFF_F);
    for (int it = 0; it < NT; ++it) {
        const int t = NT - 1 - it, bufi = it & 1;
        LAS unsigned char* Kb = lds + OFF_K + bufi * 64 * KP; LAS unsigned char* Vb = lds + OFF_V + bufi * 64 * VP; LAS unsigned char* Cb = lds + OFF_C + bufi * 256;
        *(LAS v4u*)(Kb + srow * KP + sch * 16) = kreg; *(LAS v4u*)(Vb + srow * VP + sch * 16) = vreg;
        if (MODE == 0 && tid < 16) *(LAS f32x4*)(Cb + tid * 16) = creg;
        __syncthreads();
        if (MODE == 1 && it > 0) {
            const v4u fa = *(LAS v4u*)(flags + ((it - 1) & 1) * 8), fb = *(LAS v4u*)(flags + ((it - 1) & 1) * 8 + 4);
            if ((fa.x & fa.y & fa.z & fa.w & fb.x & fb.y & fb.z & fb.w) != 0u) break;
        }
        if (it + 1 < NT) { const int tn = t - 1; kreg = *(const v4u*)(kst + (size_t)tn * 64 * QKLD); vreg = *(const v4u*)(vst + tn * 64); if (MODE == 0 && tid < 16) creg = *(const f32x4*)(Cg + tn * 64 + tid * 4); }
        if (t <= tw) {
            f32x16 p0, p1;
            if (MODE == 0) {
#pragma unroll
                for (int rg = 0; rg < 4; ++rg) { const f32x4 c0 = *(LAS f32x4*)(Cb + (8 * rg + 4 * hi) * 4), c1 = *(LAS f32x4*)(Cb + (32 + 8 * rg + 4 * hi) * 4);
#pragma unroll
                    for (int i = 0; i < 4; ++i) { p0[4 * rg + i] = cq - c0[i]; p1[4 * rg + i] = cq - c1[i]; } }
            } else {
#pragma unroll
                for (int r = 0; r < 16; ++r) { p0[r] = 0.f; p1[r] = 0.f; }
            }
#pragma unroll
            for (int d0 = 0; d0 < 4; ++d0) {
                const bf16x8 a0 = *(LAS bf16x8*)(Kb + r32 * KP + d0 * 32 + hi * 16), a1 = *(LAS bf16x8*)(Kb + (32 + r32) * KP + d0 * 32 + hi * 16);
                p0 = __builtin_amdgcn_mfma_f32_32x32x16_bf16(a0, qr[d0], p0, 0, 0, 0);
                p1 = __builtin_amdgcn_mfma_f32_32x32x16_bf16(a1, qr[d0], p1, 0, 0, 0);
            }
            const bool diag = (t == tw);
            if (MODE == 0) {
                if (diag) {
#pragma unroll
                    for (int r = 0; r < 16; ++r) { const int kk = (r & 3) + 8 * (r >> 2) + 4 * hi; if (kk > qq) p0[r] = -INFINITY; if (kk + 32 > qq) p1[r] = -INFINITY; }
                }
                float rm = fmaxf(p0[0], p1[0]);
#pragma unroll
                for (int r = 1; r < 16; ++r) rm = fmaxf(rm, fmaxf(p0[r], p1[r]));
                rm = fmaxf(rm, __shfl_xor(rm, 32));
                if (__any(rm > mrun)) {
                    const float mn = fmaxf(mrun, rm), al = ex2(mrun - mn);
                    lsum *= al;
#pragma unroll
                    for (int r = 0; r < 16; ++r) { o0[r] *= al; o1[r] *= al; }
                    mrun = mn;
                }
                float s = 0.f;
#pragma unroll
                for (int r = 0; r < 16; ++r) { p0[r] = ex2(p0[r] - mrun); p1[r] = ex2(p1[r] - mrun); s += p0[r] + p1[r]; }
                lsum += s;
            } else {
                f32x16 x0, x1;
#pragma unroll
                for (int r = 0; r < 16; ++r) {
                    x0[r] = p0[r] > 24.f ? p0[r] : lg2(1.f + ex2(p0[r]));
                    x1[r] = p1[r] > 24.f ? p1[r] : lg2(1.f + ex2(p1[r]));
                }
                if (diag) {
#pragma unroll
                    for (int r = 0; r < 16; ++r) { const int kk = (r & 3) + 8 * (r >> 2) + 4 * hi; if (kk >= qq) x0[r] = 0.f; if (kk + 32 >= qq) x1[r] = 0.f; }
                }
                float gs[8], ps[8], aft[8];
#pragma unroll
                for (int rg = 0; rg < 4; ++rg) { gs[rg] = (x0[4 * rg] + x0[4 * rg + 1]) + (x0[4 * rg + 2] + x0[4 * rg + 3]); gs[4 + rg] = (x1[4 * rg] + x1[4 * rg + 1]) + (x1[4 * rg + 2] + x1[4 * rg + 3]); }
#pragma unroll
                for (int i = 0; i < 8; ++i) ps[i] = __shfl_xor(gs[i], 32);
                float run = 0.f;
#pragma unroll
                for (int i = 7; i >= 0; --i) { aft[i] = run + (hi ? 0.f : ps[i]); run += gs[i] + ps[i]; }
#pragma unroll
                for (int rg = 0; rg < 4; ++rg) {
                    float bs = R + aft[rg];
                    x0[4 * rg + 3] += bs; x0[4 * rg + 2] += x0[4 * rg + 3]; x0[4 * rg + 1] += x0[4 * rg + 2]; x0[4 * rg] += x0[4 * rg + 1];
                    bs = R + aft[4 + rg];
                    x1[4 * rg + 3] += bs; x1[4 * rg + 2] += x1[4 * rg + 3]; x1[4 * rg + 1] += x1[4 * rg + 2]; x1[4 * rg] += x1[4 * rg + 1];
                }
                R += run;
#pragma unroll
                for (int r = 0; r < 16; ++r) { p0[r] = ex2(p0[r] - x0[r]); p1[r] = ex2(p1[r] - x1[r]); }
                if (diag) {
#pragma unroll
                    for (int r = 0; r < 16; ++r) { const int kk = (r & 3) + 8 * (r >> 2) + 4 * hi; if (kk >= qq) p0[r] = 0.f; if (kk + 32 >= qq) p1[r] = 0.f; }
                }
            }
            v4u pw[4];
#pragma unroll
            for (int j = 0; j < 2; ++j) {
                pw[j]     = (v4u){cvtpk(p0[8 * j], p0[8 * j + 1]), cvtpk(p0[8 * j + 2], p0[8 * j + 3]), cvtpk(p0[8 * j + 4], p0[8 * j + 5]), cvtpk(p0[8 * j + 6], p0[8 * j + 7])};
                pw[2 + j] = (v4u){cvtpk(p1[8 * j], p1[8 * j + 1]), cvtpk(p1[8 * j + 2], p1[8 * j + 3]), cvtpk(p1[8 * j + 4], p1[8 * j + 5]), cvtpk(p1[8 * j + 6], p1[8 * j + 7])};
            }
#pragma unroll
            for (int ks = 0; ks < 4; ++ks) {
                const bf16x8 pa = __builtin_bit_cast(bf16x8, pw[ks]);
                const s16x4 l0 = *(LAS s16x4*)(Vb + r32 * VP + (16 * ks + 4 * hi) * 2), h0 = *(LAS s16x4*)(Vb + r32 * VP + (16 * ks + 8 + 4 * hi) * 2);
                const s16x4 l1 = *(LAS s16x4*)(Vb + (32 + r32) * VP + (16 * ks + 4 * hi) * 2), h1 = *(LAS s16x4*)(Vb + (32 + r32) * VP + (16 * ks + 8 + 4 * hi) * 2);
                const bf16x8 v0 = (bf16x8){l0[0], l0[1], l0[2], l0[3], h0[0], h0[1], h0[2], h0[3]};
                const bf16x8 v1 = (bf16x8){l1[0], l1[1], l1[2], l1[3], h1[0], h1[1], h1[2], h1[3]};
                o0 = __builtin_amdgcn_mfma_f32_32x32x16_bf16(v0, pa, o0, 0, 0, 0);
                o1 = __builtin_amdgcn_mfma_f32_32x32x16_bf16(v1, pa, o1, 0, 0, 0);
            }
        }
        if (MODE == 1) { const bool done = __all(R > 150.f); if (lane == 0) flags[bufi * 8 + w] = done ? 1u : 0u; }
    }
    float inv = 1.f;
    if (MODE == 0) { const float lt = lsum + __shfl_xor(lsum, 32); inv = 1.f / lt; }
    bf16* Op = AO + (rowbase + q0 + w * 32 + r32) * 1024 + MODE * 512 + h * 64 + 4 * hi;
#pragma unroll
    for (int rg = 0; rg < 4; ++rg) {
        v2u a, c;
        a.x = cvtpk(o0[4 * rg] * inv, o0[4 * rg + 1] * inv); a.y = cvtpk(o0[4 * rg + 2] * inv, o0[4 * rg + 3] * inv);
        c.x = cvtpk(o1[4 * rg] * inv, o1[4 * rg + 1] * inv); c.y = cvtpk(o1[4 * rg + 2] * inv, o1[4 * rg + 3] * inv);
        *(v2u*)(Op + 8 * rg) = a; *(v2u*)(Op + 32 + 8 * rg) = c;
    }
    __syncthreads();
}
}
constexpr size_t MiB = 1u << 20;
constexpr size_t WS_WQK = 1 * MiB, WS_WV = 5 * MiB, WS_WOUT = 7 * MiB, WS_WMQN = 9 * MiB, WS_WMKV = 11 * MiB, WS_WMO = 15 * MiB, WS_WUP = 17 * MiB, WS_WDOWN = 28 * MiB;
constexpr size_t WS_MN = 34 * MiB, WS_KVM = 35 * MiB, WS_WK = 37 * MiB, WS_VW = 41 * MiB, WS_LF = 45 * MiB, WS_C2 = 46 * MiB;
constexpr size_t WS_H = 48 * MiB, WS_QK = 80 * MiB, WS_VT = 144 * MiB, WS_AO = 176 * MiB;
constexpr size_t WS_S = 80 * MiB, WS_P = 144 * MiB, WS_U = 80 * MiB, WS_ACT = 168 * MiB, WS_END = 256 * MiB;
static_assert(WS_U + (size_t)M * DFF * 2 <= WS_ACT && WS_ACT + (size_t)M * DFF * 2 <= WS_END, "d_ws map");

constexpr int LDS_BYTES = 147456;
constexpr int NSTEPS = 16;

struct Args { const float* in[19]; float* out; unsigned char* ws; int ph_lo, ph_hi; };

struct Ctx {
    LAS unsigned char* lds;
    int tid, lane, wave, vcu, G;
    float* out; unsigned char* ws;
};
constexpr int PARAM_OFF = 131072;
__device__ __forceinline__ const float* inp(const Ctx& F, int k) {
    volatile LAS unsigned* p = (volatile LAS unsigned*)(F.lds + PARAM_OFF) + 2 * k;
    const unsigned lo = __builtin_amdgcn_readfirstlane(p[0]), hi = __builtin_amdgcn_readfirstlane(p[1]);
    return (const float*)(((unsigned long long)hi << 32) | (unsigned long long)lo);
}

__device__ __forceinline__ void transpose_item(const float* __restrict__ W, int ldw, int c0, int ncols, bf16* __restrict__ WT, int ldt, int row_off, float scale, LAS float* scr, int item, int lane) {
    const int nblk = ncols / 32, kb = item / nblk, nb = item % nblk, k0 = 64 * kb, n0 = 32 * nb;
#pragma unroll 8
    for (int i = 0; i < 32; ++i) { const int kk = 2 * i + (lane >> 5); scr[kk * 33 + (lane & 31)] = W[(size_t)(k0 + kk) * ldw + c0 + n0 + (lane & 31)] * scale; }
    asm volatile("s_waitcnt lgkmcnt(0)" ::: "memory");
    const int c = lane & 7;
#pragma unroll
    for (int j = 0; j < 4; ++j) { const int n = (lane >> 3) + 8 * j; const LAS float* s = scr + (8 * c) * 33 + n;
        v4u o; o.x = pk2(s[0 * 33], s[1 * 33]); o.y = pk2(s[2 * 33], s[3 * 33]); o.z = pk2(s[4 * 33], s[5 * 33]); o.w = pk2(s[6 * 33], s[7 * 33]);
        *(v4u*)(WT + (size_t)(row_off + n0 + n) * ldt + k0 + 8 * c) = o; }
    asm volatile("s_waitcnt lgkmcnt(0)" ::: "memory");
}

__device__ __forceinline__ void rms_row_to_bf16(const float* __restrict__ xrow, const float* __restrict__ g, bf16* __restrict__ orow, int lane, f32x4 (&v)[4]) {
    const f32x4* xr = (const f32x4*)xrow + lane; const f32x4* gr = (const f32x4*)g + lane;
    float s2 = 0.f;
#pragma unroll
    for (int j = 0; j < 4; ++j) { v[j] = xr[64 * j]; s2 += (v[j].x * v[j].x + v[j].y * v[j].y) + (v[j].z * v[j].z + v[j].w * v[j].w); }
    const float rstd = 1.0f / sqrtf(wave_sum(s2) * (1.f / DM) + EPS);
    unsigned long long* o8 = (unsigned long long*)orow + lane;
#pragma unroll
    for (int j = 0; j < 4; ++j) { const f32x4 gg = gr[64 * j]; v[j] = v[j] * rstd * gg;
        o8[64 * j] = (unsigned long long)pk2(v[j].x, v[j].y) | ((unsigned long long)pk2(v[j].z, v[j].w) << 32); }
}

__device__ __forceinline__ float log_sigmoid(float x) { return fminf(x, 0.f) - log1pf(expf(-fabsf(x))); }

__device__ __forceinline__ void step_prologue(const Ctx& F) {
    LAS float* scr = (LAS float*)(F.lds + F.wave * 16384);
    const int gw = F.vcu * NWAVES + F.wave, NGW = F.G * NWAVES;
    unsigned char* ws = F.ws;
    const float* w_in = inp(F, 3);
    const float QS = 0.125f * LOG2E;
    constexpr int I_IN = 16 * 16, I_OUT = 16 * 32, I_MKV = 16 * 64, I_MO = 16 * 32, I_UP = 16 * 44, I_DN = 44 * 32;
    constexpr int NITEMS = 6 * I_IN + I_OUT + I_MKV + I_MO + 4 * I_UP + I_DN;
    for (int it = gw; it < NITEMS; it += NGW) {
        int r = it;
        if (r < 6 * I_IN) { const int blk = r / I_IN; r -= blk * I_IN;
            bf16* dst = (blk == 2 || blk == 5) ? (bf16*)(ws + WS_WV) : (bf16*)(ws + WS_WQK);
            const int row_off = (blk == 0) ? 0 : (blk == 1) ? 512 : (blk == 2) ? 0 : (blk == 3) ? 1024 : (blk == 4) ? 1536 : 512;
            const float sc = (blk == 0 || blk == 3) ? QS : 1.f;
            transpose_item(w_in, INC, blk * 512, 512, dst, DM, row_off, sc, scr, r, F.lane); continue; }
        r -= 6 * I_IN;
        if (r < I_OUT) { transpose_item(inp(F, 7), DM, 0, DM, (bf16*)(ws + WS_WOUT), DM, 0, 1.f, scr, r, F.lane); continue; } r -= I_OUT;
        if (r < I_MKV) { transpose_item(inp(F, 11), 2 * DM, 0, 2 * DM, (bf16*)(ws + WS_WMKV), DM, 0, 1.f, scr, r, F.lane); continue; } r -= I_MKV;
        if (r < I_MO) { transpose_item(inp(F, 12), DM, 0, DM, (bf16*)(ws + WS_WMO), DM, 0, 1.f, scr, r, F.lane); continue; } r -= I_MO;
        if (r < 4 * I_UP) { const int blk = r / I_UP; r -= blk * I_UP;
            const int c0 = (blk == 0) ? 0 : (blk == 1) ? DFF : (blk == 2) ? HFF : DFF + HFF;
            transpose_item(inp(F, 14), 2 * DFF, c0, HFF, (bf16*)(ws + WS_WUP), DM, blk * HFF, 1.f, scr, r, F.lane); continue; }
        r -= 4 * I_UP;
        transpose_item(inp(F, 17), DM, 0, DM, (bf16*)(ws + WS_WDOWN), DFF, 0, 1.f, scr, r, F.lane);
    }
    { const float* wq = inp(F, 10); bf16* dq = (bf16*)(ws + WS_WMQN); const float sc = 0.0625f * LOG2E;
      for (int i = (F.vcu * 512 + F.tid); i < DM * DM / 4; i += F.G * 512) { const f32x4 v = ((const f32x4*)wq)[i]; v2u o; o.x = pk2(v.x * sc, v.y * sc); o.y = pk2(v.z * sc, v.w * sc); ((v2u*)dq)[i] = o; } }
    { const float* x = inp(F, 0); const float* g = inp(F, 2); const float* bfg = inp(F, 4); bf16* H = (bf16*)(ws + WS_H); float* LF = (float*)(ws + WS_LF);
      for (int m = gw; m < M; m += NGW) {
          f32x4 v[4]; rms_row_to_bf16(x + (size_t)m * DM, g, H + (size_t)m * DM, F.lane, v);
          float acc[8];
#pragma unroll
          for (int j = 0; j < 8; ++j) acc[j] = 0.f;
#pragma unroll
          for (int j = 0; j < 4; ++j)
#pragma unroll
              for (int e = 0; e < 4; ++e) { const int k = 4 * F.lane + 256 * j + e; const f32x4 wa = *(const f32x4*)(w_in + (size_t)k * INC + 3072), wb = *(const f32x4*)(w_in + (size_t)k * INC + 3076); const float hv = v[j][e];
                  acc[0] += hv * wa.x; acc[1] += hv * wa.y; acc[2] += hv * wa.z; acc[3] += hv * wa.w; acc[4] += hv * wb.x; acc[5] += hv * wb.y; acc[6] += hv * wb.z; acc[7] += hv * wb.w; }
#pragma unroll
          for (int j = 0; j < 8; ++j) acc[j] = wave_sum(acc[j]);
          if (F.lane < 8) { float a = acc[0];
#pragma unroll
              for (int j = 1; j < 8; ++j) a = (F.lane == j) ? acc[j] : a;
              const int bb = m / SEQ, s = m % SEQ; LF[(size_t)(bb * 8 + F.lane) * SEQ + s] = log_sigmoid(a + bfg[F.lane]); }
      } }
    { const float* mem = inp(F, 1); const float* g = inp(F, 9); bf16* MN = (bf16*)(ws + WS_MN);
      for (int m = gw; m < BATCH * NMEM; m += NGW) { f32x4 v[4]; rms_row_to_bf16(mem + (size_t)m * DM, g, MN + (size_t)m * DM, F.lane, v); } }
}

__device__ __forceinline__ void step_scan(const Ctx& F) {
    if (blockIdx.x >= 2) return;
    const int seq = blockIdx.x * 8 + F.wave;
    const float* src = (const float*)(F.ws + WS_LF) + (size_t)seq * SEQ + F.lane * 128; float* dst = (float*)(F.ws + WS_C2) + (size_t)seq * SEQ + F.lane * 128;
    float tot = 0.f;
    for (int i = 0; i < 32; ++i) { const f32x4 v = ((const f32x4*)src)[i]; tot += v.x; tot += v.y; tot += v.z; tot += v.w; }
    float inc = tot;
#pragma unroll
    for (int o = 1; o < 64; o <<= 1) { const float u = __shfl_up(inc, o); if (F.lane >= o) inc += u; }
    float run = inc - tot;
    for (int i = 0; i < 32; ++i) { const f32x4 v = ((const f32x4*)src)[i]; f32x4 o; run += v.x; o.x = run * LOG2E; run += v.y; o.y = run * LOG2E; run += v.z; o.z = run * LOG2E; run += v.w; o.w = run * LOG2E; ((f32x4*)dst)[i] = o; }
}

__device__ __forceinline__ void step_mixnorm(const Ctx& F) {
    const int gw = F.vcu * NWAVES + F.wave, NGW = F.G * NWAVES; bf16* AO = (bf16*)(F.ws + WS_AO);
    const float* gf = inp(F, 5); const float* gs = inp(F, 6);
    for (int m = gw; m < M; m += NGW) {
        v4u* row = (v4u*)(AO + (size_t)m * DM) + F.lane;
#pragma unroll
        for (int hf = 0; hf < 2; ++hf) {
            const v4u w = row[64 * hf]; float v[8];
            v[0] = bflo(w.x); v[1] = bfhi(w.x); v[2] = bflo(w.y); v[3] = bfhi(w.y); v[4] = bflo(w.z); v[5] = bfhi(w.z); v[6] = bflo(w.w); v[7] = bfhi(w.w);
            float s2 = 0.f;
#pragma unroll
            for (int e = 0; e < 8; ++e) s2 += v[e] * v[e];
            const float rstd = 1.0f / sqrtf(wave_sum(s2) * (1.f / 512.f) + EPS);
            const float* g = (hf ? gs : gf) + 8 * F.lane; const f32x4 ga = *(const f32x4*)g, gb = *(const f32x4*)(g + 4);
            v4u o; o.x = pk2(v[0] * rstd * ga.x, v[1] * rstd * ga.y); o.y = pk2(v[2] * rstd * ga.z, v[3] * rstd * ga.w); o.z = pk2(v[4] * rstd * gb.x, v[5] * rstd * gb.y); o.w = pk2(v[6] * rstd * gb.z, v[7] * rstd * gb.w);
            row[64 * hf] = o;
        }
    }
}

__device__ __forceinline__ void step_rms(const Ctx& F, const float* g) {
    const int gw = F.vcu * NWAVES + F.wave, NGW = F.G * NWAVES; bf16* H = (bf16*)(F.ws + WS_H);
    for (int m = gw; m < M; m += NGW) { f32x4 v[4]; rms_row_to_bf16(F.out + (size_t)m * DM, g, H + (size_t)m * DM, F.lane, v); }
}

__device__ __forceinline__ void step_final(const Ctx& F) {
    const int gw = F.vcu * NWAVES + F.wave, NGW = F.G * NWAVES; const float* g = inp(F, 18);
    for (int m = gw; m < M; m += NGW) {
        f32x4* xr = (f32x4*)(F.out + (size_t)m * DM) + F.lane; const f32x4* gr = (const f32x4*)g + F.lane; f32x4 v[4]; float s2 = 0.f;
#pragma unroll
        for (int j = 0; j < 4; ++j) { v[j] = xr[64 * j]; s2 += (v[j].x * v[j].x + v[j].y * v[j].y) + (v[j].z * v[j].z + v[j].w * v[j].w); }
        const float rstd = 1.0f / sqrtf(wave_sum(s2) * (1.f / DM) + EPS);
#pragma unroll
        for (int j = 0; j < 4; ++j) xr[64 * j] = v[j] * rstd * gr[64 * j];
    }
}

__device__ __forceinline__ void step_memsoftmax(const Ctx& F) {
    const int gw = F.vcu * NWAVES + F.wave, NGW = F.G * NWAVES; const float* S = (const float*)(F.ws + WS_S); bf16* P = (bf16*)(F.ws + WS_P);
    for (int m = gw; m < M; m += NGW) {
        const f32x4* sr = (const f32x4*)(S + (size_t)m * DM) + F.lane; unsigned long long* o8 = (unsigned long long*)(P + (size_t)m * DM) + F.lane;
#pragma unroll
        for (int j = 0; j < 4; ++j) { f32x4 v = sr[64 * j];
            const float mx = wave_max(fmaxf(fmaxf(v.x, v.y), fmaxf(v.z, v.w)));
            v.x = att::ex2(v.x - mx); v.y = att::ex2(v.y - mx); v.z = att::ex2(v.z - mx); v.w = att::ex2(v.w - mx);
            const float inv = 1.f / wave_sum((v.x + v.y) + (v.z + v.w));
            o8[64 * j] = (unsigned long long)pk2(v.x * inv, v.y * inv) | ((unsigned long long)pk2(v.z * inv, v.w * inv) << 32); }
    }
}

__device__ __forceinline__ void step_conv(const Ctx& F, int half) {
    const bf16* U = (const bf16*)(F.ws + WS_U); bf16* ACT = (bf16*)(F.ws + WS_ACT); const float* cw = inp(F, 15); const float* cb = inp(F, 16);
    constexpr int NCC = HFF / 8  , NRC = M / 16, NIT = NCC * NRC;
    for (int item = F.vcu * 512 + F.tid; item < NIT; item += F.G * 512) {
        const int cc = item % NCC, rc = item / NCC, t0 = rc * 16, j0 = cc * 8, fg = half * HFF + j0, fv = DFF + fg;
        float wg[3][8], wv[3][8], bg[8], bv[8];
#pragma unroll
        for (int i = 0; i < 3; ++i)
#pragma unroll
            for (int e = 0; e < 8; e += 4) { const f32x4 a = *(const f32x4*)(cw + (size_t)i * 2 * DFF + fg + e), c = *(const f32x4*)(cw + (size_t)i * 2 * DFF + fv + e);
                wg[i][e] = a.x; wg[i][e + 1] = a.y; wg[i][e + 2] = a.z; wg[i][e + 3] = a.w; wv[i][e] = c.x; wv[i][e + 1] = c.y; wv[i][e + 2] = c.z; wv[i][e + 3] = c.w; }
#pragma unroll
        for (int e = 0; e < 8; e += 4) { const f32x4 a = *(const f32x4*)(cb + fg + e), c = *(const f32x4*)(cb + fv + e);
            bg[e] = a.x; bg[e + 1] = a.y; bg[e + 2] = a.z; bg[e + 3] = a.w; bv[e] = c.x; bv[e + 1] = c.y; bv[e + 2] = c.z; bv[e + 3] = c.w; }
        float g2[8], g1[8], v2[8], v1[8];
        const bool first = (t0 % SEQ) == 0;
        {
            v4u a = {0u, 0u, 0u, 0u}, b = a, c = a, d = a;
            if (!first) { a = *(const v4u*)(U + (size_t)(t0 - 2) * DFF + j0); b = *(const v4u*)(U + (size_t)(t0 - 1) * DFF + j0); c = *(const v4u*)(U + (size_t)(t0 - 2) * DFF + HFF + j0); d = *(const v4u*)(U + (size_t)(t0 - 1) * DFF + HFF + j0); }
            g2[0] = bflo(a.x); g2[1] = bfhi(a.x); g2[2] = bflo(a.y); g2[3] = bfhi(a.y); g2[4] = bflo(a.z); g2[5] = bfhi(a.z); g2[6] = bflo(a.w); g2[7] = bfhi(a.w);
            g1[0] = bflo(b.x); g1[1] = bfhi(b.x); g1[2] = bflo(b.y); g1[3] = bfhi(b.y); g1[4] = bflo(b.z); g1[5] = bfhi(b.z); g1[6] = bflo(b.w); g1[7] = bfhi(b.w);
            v2[0] = bflo(c.x); v2[1] = bfhi(c.x); v2[2] = bflo(c.y); v2[3] = bfhi(c.y); v2[4] = bflo(c.z); v2[5] = bfhi(c.z); v2[6] = bflo(c.w); v2[7] = bfhi(c.w);
            v1[0] = bflo(d.x); v1[1] = bfhi(d.x); v1[2] = bflo(d.y); v1[3] = bfhi(d.y); v1[4] = bflo(d.z); v1[5] = bfhi(d.z); v1[6] = bflo(d.w); v1[7] = bfhi(d.w);
        }
#pragma unroll 4
        for (int rr = 0; rr < 16; ++rr) {
            const size_t t = (size_t)(t0 + rr);
            const v4u a = *(const v4u*)(U + t * DFF + j0), c = *(const v4u*)(U + t * DFF + HFF + j0);
            float g0[8], v0[8], o[8];
            g0[0] = bflo(a.x); g0[1] = bfhi(a.x); g0[2] = bflo(a.y); g0[3] = bfhi(a.y); g0[4] = bflo(a.z); g0[5] = bfhi(a.z); g0[6] = bflo(a.w); g0[7] = bfhi(a.w);
            v0[0] = bflo(c.x); v0[1] = bfhi(c.x); v0[2] = bflo(c.y); v0[3] = bfhi(c.y); v0[4] = bflo(c.z); v0[5] = bfhi(c.z); v0[6] = bflo(c.w); v0[7] = bfhi(c.w);
#pragma unroll
            for (int e = 0; e < 8; ++e) {
                const float gt = bg[e] + wg[0][e] * g2[e] + wg[1][e] * g1[e] + wg[2][e] * g0[e];
                const float vl = bv[e] + wv[0][e] * v2[e] + wv[1][e] * v1[e] + wv[2][e] * v0[e];
                o[e] = gt / (1.f + __expf(-gt)) * vl;
                g2[e] = g1[e]; g1[e] = g0[e]; v2[e] = v1[e]; v1[e] = v0[e];
            }
            v4u ov; ov.x = pk2(o[0], o[1]); ov.y = pk2(o[2], o[3]); ov.z = pk2(o[4], o[5]); ov.w = pk2(o[6], o[7]);
            *(v4u*)(ACT + t * DFF + fg) = ov;
        }
    }
}

__device__ __forceinline__ void step_attention(const Ctx& F) {
    const bf16* QK = (const bf16*)(F.ws + WS_QK); const bf16* VT = (const bf16*)(F.ws + WS_VT); const float* C2 = (const float*)(F.ws + WS_C2); bf16* AO = (bf16*)(F.ws + WS_AO);
#pragma nounroll
    for (int id = F.vcu; id < 512; id += F.G) { const int v = id & 255, bh = v >> 4, s = v & 15, qb = (id >> 8) ? 31 - s : s; att::unit<0>(bh >> 3, bh & 7, qb, QK, VT, C2, AO, F.lds); }
#pragma nounroll
    for (int id = F.vcu; id < 512; id += F.G) { const int v = id & 255, bh = v >> 4, s = v & 15, qb = (id >> 8) ? 31 - s : s; att::unit<1>(bh >> 3, bh & 7, qb, QK, VT, C2, AO, F.lds); }
}

struct Job { pg8::Gemm g; int G, c; bf16* O; int ldc; const float* base; float* out; };

__device__ __forceinline__ bool bf16_job(const Ctx& F, int step, int j, Job& J) {
    unsigned char* ws = F.ws; const int bx = (int)blockIdx.x;
    J.G = F.G; J.c = bx; J.base = nullptr; J.out = nullptr;
    if (step == 1) {
        if (j == 0) { J.g = pg8::Gemm{(const bf16*)(ws + WS_H), (const bf16*)(ws + WS_WQK), M, 2048, DM, DM, DM}; J.O = (bf16*)(ws + WS_QK); J.ldc = 2048; return true; }
        if (j == 1) { J.g = pg8::Gemm{(const bf16*)(ws + WS_WV), (const bf16*)(ws + WS_H), DM, M, DM, DM, DM}; J.O = (bf16*)(ws + WS_VT); J.ldc = M; return true; }
        if (j == 2) { J.g = pg8::Gemm{(const bf16*)(ws + WS_MN), (const bf16*)(ws + WS_WMKV), BATCH * NMEM, 2 * DM, DM, DM, DM}; J.O = (bf16*)(ws + WS_KVM); J.ldc = 2 * DM; return true; }
        return false;
    }
    if (step == 3) {
        if (j != 0 || bx >= 64) return false;
        const int ci = bx >> 2, kind = ci >> 3, bb = (ci >> 2) & 1, hh = ci & 3; J.G = 4; J.c = bx & 3;
        const bf16* KVM = (const bf16*)(ws + WS_KVM);
        if (kind == 0) {
            J.g = pg8::Gemm{KVM + (size_t)(bb * NMEM) * 2048 + hh * 256, (const bf16*)(ws + WS_WMQN) + hh * 256, 256, DM, 256, 2048, DM};
            J.O = (bf16*)(ws + WS_WK) + (size_t)(bb * DM + hh * 256) * DM; J.ldc = DM;
        } else {
            J.g = pg8::Gemm{(const bf16*)(ws + WS_WMO) + hh * 256, KVM + (size_t)(bb * NMEM) * 2048 + DM + hh * 256, DM, 256, 256, DM, 2048};
            J.O = (bf16*)(ws + WS_VW) + (size_t)bb * DM * DM + hh * 256; J.ldc = DM;
        }
        return true;
    }
    if (step == 10 || step == 12) {
        if (j != 0) return false;
        const int half = (step == 12);
        J.g = pg8::Gemm{(const bf16*)(ws + WS_H), (const bf16*)(ws + WS_WUP) + (size_t)half * DFF * DM, M, DFF, DM, DM, DM}; J.O = (bf16*)(ws + WS_U); J.ldc = DFF; return true;
    }
    return false;
}
__device__ __forceinline__ bool f32_job(const Ctx& F, int step, Job& J) {
    unsigned char* ws = F.ws; const int bx = (int)blockIdx.x;
    J.G = F.G; J.c = bx; J.O = nullptr;
    if (step == 4) { J.g = pg8::Gemm{(const bf16*)(ws + WS_AO), (const bf16*)(ws + WS_WOUT), M, DM, DM, DM, DM}; J.base = inp(F, 0); J.out = F.out; J.ldc = DM; return true; }
    if (step == 6 || step == 8) {
        const int bb = bx & 1; J.G = F.G >> 1; J.c = bx >> 1;
        if ((F.G & 1) && bx == F.G - 1) return false;
        if (step == 6) { J.g = pg8::Gemm{(const bf16*)(ws + WS_H) + (size_t)bb * SEQ * DM, (const bf16*)(ws + WS_WK) + (size_t)bb * DM * DM, SEQ, DM, DM, DM, DM}; J.base = nullptr; J.out = (float*)(ws + WS_S) + (size_t)bb * SEQ * DM; }
        else           { J.g = pg8::Gemm{(const bf16*)(ws + WS_P) + (size_t)bb * SEQ * DM, (const bf16*)(ws + WS_VW) + (size_t)bb * DM * DM, SEQ, DM, DM, DM, DM}; J.out = F.out + (size_t)bb * SEQ * DM; J.base = J.out; }
        J.ldc = DM; return true;
    }
    if (step == 14) { J.g = pg8::Gemm{(const bf16*)(ws + WS_ACT), (const bf16*)(ws + WS_WDOWN), M, DM, DFF, DFF, DFF}; J.base = F.out; J.out = F.out; J.ldc = DM; return true; }
    return false;
}

__global__ void __launch_bounds__(NWAVES * 64, 2) fwd_kernel(Args args) {
    extern __shared__ __attribute__((aligned(16))) unsigned char lds[];
    cg::grid_group grid = cg::this_grid();
    Ctx F0;
    F0.lds = (LAS unsigned char*)lds; F0.tid = threadIdx.x; F0.lane = F0.tid & 63; F0.wave = __builtin_amdgcn_readfirstlane(F0.tid >> 6);
    F0.G = gridDim.x; { const int bx = blockIdx.x; F0.vcu = (F0.G % 8 == 0) ? (bx % 8) * (F0.G / 8) + bx / 8 : bx; }
    F0.out = args.out; F0.ws = args.ws;
    if (F0.tid == 0) { LAS unsigned long long* pl = (LAS unsigned long long*)(F0.lds + PARAM_OFF);
#pragma unroll
        for (int i = 0; i < 19; ++i) pl[i] = (unsigned long long)args.in[i]; }
    __syncthreads();
    const int lo = args.ph_lo, hi = args.ph_hi;
#pragma nounroll
    for (int step = lo; step < hi; ++step) {
        Ctx F = F0;
        asm volatile("" : "+v"(F.tid)); F.lane = F.tid & 63; F.wave = __builtin_amdgcn_readfirstlane(F.tid >> 6);
        asm volatile("" : "+s"(F.vcu), "+s"(F.G), "+s"(F.ws), "+s"(F.out));
        switch (step) {
            case 0: step_prologue(F); break;
            case 1: step_scan(F); break;
            case 2: step_attention(F); break;
            case 3: step_mixnorm(F); break;
            case 5: step_rms(F, inp(F, 8)); break;
            case 7: step_memsoftmax(F); break;
            case 9: step_rms(F, inp(F, 13)); break;
            case 11: step_conv(F, 0); break;
            case 13: step_conv(F, 1); break;
            case 15: step_final(F); break;
            default: break;
        }
        __syncthreads();
#pragma nounroll
        for (int j = 0; j < 3; ++j) {
            Job J;
            if (!bf16_job(F, step, j, J)) break;
            pg8::StaticOrder S; S.init(J.g.M, J.g.N, J.G, J.c);
            pg8::EpiBf16<0> E{J.O, J.ldc, nullptr, 0, 0, 1.f};
            pg8::gemm_phase<pg8::EpiBf16<0>, pg8::StaticOrder, PG8_ALIGN, PG8_SP2>(F.lds, J.g, S, E);
            __syncthreads();
        }
        {
            Job J;
            if (f32_job(F, step, J)) {
                pg8::StaticOrder S; S.init(J.g.M, J.g.N, J.G, J.c);
                pg8::EpiResF32 E{J.base, J.out, J.ldc};
                pg8::gemm_phase<pg8::EpiResF32, pg8::StaticOrder, PG8_ALIGN, PG8_SP2>(F.lds, J.g, S, E);
                __syncthreads();
            }
        }
        if (step + 1 < hi) grid.sync();
    }
}

#ifndef MK_PER_STEP
#define MK_PER_STEP 0
#endif
extern "C" void kernel_launch(void* const* d_in, const int* in_sizes, int n_in, void* d_out, int out_size, void* d_ws, size_t ws_size, hipStream_t stream) {
    static int grid = 0;
    if (grid == 0) {
        if (n_in != 19 || in_sizes[0] != M * DM || out_size != M * DM || ws_size < WS_END) { fprintf(stderr, "kernel_launch: unexpected shapes (n_in %d, in0 %d, out %d, ws %zu)\n", n_in, n_in > 0 ? in_sizes[0] : -1, out_size, ws_size); grid = -1; return; }
        int dev = 0, cus = 0, per_cu = 0;
        if (hipGetDevice(&dev) != hipSuccess || hipDeviceGetAttribute(&cus, hipDeviceAttributeMultiprocessorCount, dev) != hipSuccess) { grid = -1; return; }
        if (hipFuncSetAttribute((const void*)fwd_kernel, hipFuncAttributeMaxDynamicSharedMemorySize, LDS_BYTES) != hipSuccess) { fprintf(stderr, "kernel_launch: hipFuncSetAttribute failed\n"); grid = -1; return; }
        if (hipOccupancyMaxActiveBlocksPerMultiprocessor(&per_cu, (const void*)fwd_kernel, NWAVES * 64, LDS_BYTES) != hipSuccess || per_cu < 1) { fprintf(stderr, "kernel_launch: occupancy query says %d\n", per_cu); per_cu = 1; }
        (void)hipGetLastError();
        grid = cus;
    }
    if (grid < 0) return;
    Args a{};
    for (int i = 0; i < 19; ++i) a.in[i] = (const float*)d_in[i];
    a.out = (float*)d_out; a.ws = (unsigned char*)d_ws;
#if MK_PER_STEP
    for (int s = 0; s < NSTEPS; ++s) { a.ph_lo = s; a.ph_hi = s + 1; hipLaunchKernelGGL(fwd_kernel, dim3(grid), dim3(NWAVES * 64), LDS_BYTES, stream, a); }
#else
    a.ph_lo = 0; a.ph_hi = NSTEPS;
    void* kargs[] = {&a};
    const hipError_t e = hipLaunchCooperativeKernel((const void*)fwd_kernel, dim3(grid), dim3(NWAVES * 64), kargs, LDS_BYTES, stream);
    if (e != hipSuccess) fprintf(stderr, "kernel_launch: cooperative launch failed: %s (grid %d)\n", hipGetErrorString(e), grid);
#endif
}
```

```cpp
#include <hip/hip_runtime.h>
#include <hip/hip_cooperative_groups.h>
#include <cstdio>
#include <cstdint>
namespace cg = cooperative_groups;
namespace pg8 {
#define PG8_LAS __attribute__((address_space(3)))
typedef unsigned short bf16_t;
typedef short bf16x8 __attribute__((ext_vector_type(8)));
typedef float f32x4 __attribute__((ext_vector_type(4)));
typedef unsigned u32x4 __attribute__((ext_vector_type(4)));
constexpr int BM = 256, BK = 64, HALF = 128, HTB = HALF * BK * 2  , STAGE_BYTES = 8 * HTB, NXCD = 8, WGM = 8;

__host__ __device__ __forceinline__ int lds_byte(int r, int c) { const int st = (r >> 4) * 2 + (c >> 5), rr = r & 15, cc = c & 31, ob = rr * 64 + cc * 2; return st * 1024 + (ob ^ (((ob >> 9) & 1) << 5)); }
__host__ __device__ __forceinline__ void stage_rc(int b, int& R, int& C) { const int st = b / 1024, sb = b % 1024, swz = sb ^ (((sb >> 9) & 1) << 5); R = (st >> 1) * 16 + swz / 64; C = (st & 1) * 32 + (swz % 64) / 2; }
__host__ __device__ __forceinline__ int perm32(int rho) { const int n = rho >> 4, i = rho & 15; return 8 * (i >> 2) + 4 * n + (i & 3); }

struct Unit { int pm, pn; };
struct Gemm { const bf16_t* A; const bf16_t* Bt; int M, N, K, lda, ldb; };

struct StaticOrder {
    int nM, nN, nwg, G, c;
    __host__ __device__ void init(int M, int N, int G_, int c_) { nM = M / BM; nN = N / BM; nwg = nM * nN; G = G_; c = c_; }
    __host__ __device__ bool next(int i, Unit& u) const {
        const long L = (long)i * G + c; if (L >= nwg) return false;
        int wgid = (int)L; { const int q = nwg / NXCD, r = nwg % NXCD, xcd = wgid % NXCD, off = wgid / NXCD; wgid = (xcd < r ? xcd * (q + 1) : r * (q + 1) + (xcd - r) * q) + off; }
        const int nig = WGM * nN, gid = wgid / nig, fm = gid * WGM, gsz = (nM - fm) < WGM ? (nM - fm) : WGM;
        u.pm = fm + ((wgid % nig) % gsz); u.pn = (wgid % nig) / gsz; return true;
    }
    __device__ __forceinline__ void a_ready(const Unit&) const {}
    __device__ __forceinline__ void done(const Unit&) const {}
};

__device__ __forceinline__ unsigned cvt_pk_bf16(float lo, float hi) { unsigned r; asm volatile("v_cvt_pk_bf16_f32 %0, %1, %2" : "=v"(r) : "v"(lo), "v"(hi)); return r; }
typedef float f32x2 __attribute__((ext_vector_type(2)));
__device__ __forceinline__ f32x2 gelu_pk(f32x2 v) {
    const f32x2 av = __builtin_elementwise_abs(v), d = av * 0.2316418882f + 1.0f;
    f32x2 t; t.x = __builtin_amdgcn_rcpf(d.x); t.y = __builtin_amdgcn_rcpf(d.y);
    f32x2 q = t * 0.5307027145f + (-0.7265760135f); q = q * t + 0.7107068705f; q = q * t + (-0.142248368f); q = q * t + 0.127414796f; q = q * t;
    const f32x2 s = (v * v) * (-0.72134752044f);
    f32x2 e; e.x = __builtin_amdgcn_exp2f(s.x); e.y = __builtin_amdgcn_exp2f(s.y);
    const f32x2 m = v * (q * e), r = v - m;
    f32x2 o; o.x = v.x < 0.f ? m.x : r.x; o.y = v.y < 0.f ? m.y : r.y; return o;
}

template <int ACT  > struct EpiBf16 {
    static constexpr bool PERM = true, AFTER_DRAIN = false; static_assert(ACT == 0 || ACT == 1, "EpiBf16: ACT is 0 (none) or 1 (gelu_pk)");
    bf16_t* O; int ldc; const float* bias; int split_cols; size_t split_stride; float scale0;
    __device__ __forceinline__ void operator()(const f32x4 (&acc)[2][2][4][2], const Unit& u, int wr, int wc, int fr, int fq) const {
        const int row0 = u.pm * BM + wr * 64 + fr; int colt = u.pn * BM; bf16_t* base = O;
        float sc = 1.f; if (split_cols) { const int t = colt / split_cols; base += (size_t)t * split_stride; colt -= t * split_cols; if (t == 0) sc = scale0; }
        const int col0 = colt + wc * 32 + 8 * fq, bcol0 = u.pn * BM + wc * 32 + 8 * fq;
        f32x4 bv[2][2];
#pragma unroll
        for (int bj = 0; bj < 2; ++bj)
#pragma unroll
            for (int n = 0; n < 2; ++n) bv[bj][n] = bias ? *(const f32x4*)(bias + bcol0 + bj * HALF + 4 * n) : (f32x4){0.f, 0.f, 0.f, 0.f};
#pragma unroll
        for (int ai = 0; ai < 2; ++ai)
#pragma unroll
            for (int m = 0; m < 4; ++m) { bf16_t* rowp = base + (size_t)(row0 + ai * HALF + m * 16) * ldc + col0;
#pragma unroll
                for (int bj = 0; bj < 2; ++bj) { f32x4 v0 = acc[ai][bj][m][0] + bv[bj][0], v1 = acc[ai][bj][m][1] + bv[bj][1];
                    if (ACT == 1) { f32x2 a = gelu_pk((f32x2){v0[0], v0[1]}), b = gelu_pk((f32x2){v0[2], v0[3]}), c = gelu_pk((f32x2){v1[0], v1[1]}), d = gelu_pk((f32x2){v1[2], v1[3]});
                        v0 = (f32x4){a.x, a.y, b.x, b.y}; v1 = (f32x4){c.x, c.y, d.x, d.y}; }
                    v0 = v0 * sc; v1 = v1 * sc; u32x4 w; w.x = cvt_pk_bf16(v0[0], v0[1]); w.y = cvt_pk_bf16(v0[2], v0[3]); w.z = cvt_pk_bf16(v1[0], v1[1]); w.w = cvt_pk_bf16(v1[2], v1[3]);
                    *(u32x4*)(rowp + bj * HALF) = w; } }
    }
};
struct EpiResF32 {
    static constexpr bool PERM = false, AFTER_DRAIN = false;
    const float* base; float* out; int ldc;
    __device__ __forceinline__ void operator()(const f32x4 (&acc)[2][2][4][2], const Unit& u, int wr, int wc, int fr, int fq) const {
        const int col0 = u.pn * BM + wc * 32 + 4 * fq;
#pragma unroll
        for (int ai = 0; ai < 2; ++ai)
#pragma unroll
            for (int m = 0; m < 4; ++m) { const size_t off = (size_t)(u.pm * BM + ai * HALF + wr * 64 + m * 16 + fr) * ldc + col0;
#pragma unroll
                for (int bj = 0; bj < 2; ++bj)
#pragma unroll
                    for (int n = 0; n < 2; ++n) { f32x4 v = acc[ai][bj][m][n]; if (base) v += *(const f32x4*)(base + off + bj * HALF + n * 16); *(f32x4*)(out + off + bj * HALF + n * 16) = v; } }
    }
};
template <class Epi, class Sched, bool ALIGN_EPI = false, bool SP2 = false>
__device__ __forceinline__ void gemm_phase(PG8_LAS unsigned char* lds, const Gemm g, const Sched& S, const Epi& E) {
    int tid_ = threadIdx.x; asm volatile("" : "+v"(tid_));
    const int tid = tid_, wid = __builtin_amdgcn_readfirstlane(tid >> 6), lane = tid & 63, wr = wid >> 2, wc = wid & 3, fr = lane & 15, fq = lane >> 4;
    const int K = g.K, nt = K / BK;
    unsigned voffA[2], voffB[2];
#pragma unroll
    for (int i = 0; i < 2; ++i) { int R, C; stage_rc(tid * 16 + i * 8192, R, C); const int Rb = Epi::PERM ? ((R & ~31) + perm32(R & 31)) : R;
        voffA[i] = (unsigned)(R * g.lda + C) * 2u; voffB[i] = (unsigned)(Rb * g.ldb + C) * 2u; }
    const size_t kstep = (size_t)(BK * 2);
    const size_t hstepA = (size_t)HALF * g.lda * 2, hstepB = (size_t)HALF * g.ldb * 2;
    const size_t tstepA = 2 * hstepA, tstepB = 2 * hstepB;
    const unsigned ldsw = (unsigned)wid * 1024u;
    const int aoff = lds_byte(wr * 64 + fr, fq * 8), boff = lds_byte(wc * 32 + fr, fq * 8);
#define PG8_SA(b, h) (((b) * 2 + (h)) * HTB)
#define PG8_SB(b, h) ((4 + (b) * 2 + (h)) * HTB)
#define PG8_STAGE(bufoff, gbase, voff) do { _Pragma("unroll") for (int _i = 0; _i < 2; ++_i) \
        __builtin_amdgcn_global_load_lds((const unsigned*)((const char*)(gbase) + (voff)[_i]), (PG8_LAS unsigned*)(lds + (bufoff) + ldsw + _i * 8192), 16, 0, 0); } while (0)
#define PG8_LDA(dst, b, h) do { _Pragma("unroll") for (int m = 0; m < 4; ++m) _Pragma("unroll") for (int k = 0; k < 2; ++k) dst[m][k] = *(const PG8_LAS bf16x8*)(lds + PG8_SA(b, h) + aoff + m * 2048 + k * 1024); } while (0)
#define PG8_LDB(dst, b, h) do { _Pragma("unroll") for (int n = 0; n < 2; ++n) _Pragma("unroll") for (int k = 0; k < 2; ++k) dst[n][k] = *(const PG8_LAS bf16x8*)(lds + PG8_SB(b, h) + boff + n * 2048 + k * 1024); } while (0)
#define PG8_MMA(ai, bj, At, Bt) do { __builtin_amdgcn_s_setprio(1); _Pragma("unroll") for (int m = 0; m < 4; ++m) _Pragma("unroll") for (int n = 0; n < 2; ++n) _Pragma("unroll") for (int k = 0; k < 2; ++k) \
        acc[ai][bj][m][n] = __builtin_amdgcn_mfma_f32_16x16x32_bf16(Bt[n][k], At[m][k], acc[ai][bj][m][n], 0, 0, 0); __builtin_amdgcn_s_setprio(0); } while (0)
#define PG8_WAIT_V(n) asm volatile("s_waitcnt vmcnt(" #n ")" ::: "memory")
#define PG8_WAIT_L(n) asm volatile("s_waitcnt lgkmcnt(" #n ")" ::: "memory")
#define PG8_BAR __builtin_amdgcn_s_barrier()
#define PG8_SCHED __builtin_amdgcn_sched_barrier(0)
    Unit cur, nxt; int ui = 0;
    if (!S.next(0, cur)) return;
    f32x4 acc[2][2][4][2];
#pragma unroll
    for (int a = 0; a < 2; ++a)
#pragma unroll
        for (int b = 0; b < 2; ++b)
#pragma unroll
            for (int m = 0; m < 4; ++m)
#pragma unroll
                for (int n = 0; n < 2; ++n) acc[a][b][m][n] = (f32x4){0.f, 0.f, 0.f, 0.f};
    bf16x8 At[4][2], B0[2][2], B1[2][2];
    const char* cA = (const char*)g.A + (size_t)cur.pm * tstepA; const char* cB = (const char*)g.Bt + (size_t)cur.pn * tstepB;
    S.a_ready(cur);
    if constexpr (SP2) {
        PG8_STAGE(PG8_SB(0, 0), cB, voffB); PG8_STAGE(PG8_SB(0, 1), cB + hstepB, voffB); PG8_STAGE(PG8_SA(0, 0), cA, voffA); PG8_STAGE(PG8_SA(0, 1), cA + hstepA, voffA);
        if (wr == 1) PG8_BAR;
        PG8_WAIT_V(2); PG8_BAR;
        PG8_STAGE(PG8_SB(1, 0), cB + kstep, voffB); PG8_STAGE(PG8_SA(1, 0), cA + kstep, voffA); PG8_STAGE(PG8_SB(1, 1), cB + hstepB + kstep, voffB);
        PG8_WAIT_V(6); PG8_BAR;
    } else {
        PG8_STAGE(PG8_SB(0, 0), cB, voffB); PG8_STAGE(PG8_SA(0, 0), cA, voffA); PG8_STAGE(PG8_SB(0, 1), cB + hstepB, voffB); PG8_STAGE(PG8_SA(0, 1), cA + hstepA, voffA);
        if (wr == 1) PG8_BAR;
        PG8_WAIT_V(4); PG8_BAR;
        PG8_STAGE(PG8_SB(1, 0), cB + kstep, voffB); PG8_STAGE(PG8_SA(1, 0), cA + kstep, voffA); PG8_STAGE(PG8_SB(1, 1), cB + hstepB + kstep, voffB);
        PG8_WAIT_V(6); PG8_BAR;
    }
    for (;;) {
        const bool has_next = S.next(ui + 1, nxt);
        const char* nA = has_next ? (const char*)g.A + (size_t)nxt.pm * tstepA : cA; const char* nB = has_next ? (const char*)g.Bt + (size_t)nxt.pn * tstepB : cB;
        for (int t = 0; t < nt; t += 2) {
            const bool last = (t == nt - 2);
            const char* a1 = cA + (size_t)(t + 1) * kstep;
            const char* a2 = last ? nA : cA + (size_t)(t + 2) * kstep; const char* b2 = last ? nB : cB + (size_t)(t + 2) * kstep;
            const char* a3 = a2 + kstep; const char* b3 = b2 + kstep;
            if (last && has_next) S.a_ready(nxt);
            if constexpr (SP2) {
            PG8_LDB(B0, 0, 0); PG8_LDB(B1, 0, 1); PG8_SCHED; PG8_LDA(At, 0, 0); PG8_STAGE(PG8_SA(1, 1), a1 + hstepA, voffA);
            PG8_WAIT_V(8); PG8_WAIT_L(0); PG8_BAR; PG8_MMA(0, 0, At, B0); PG8_MMA(0, 1, At, B1); PG8_BAR; PG8_SCHED;
            PG8_LDA(At, 0, 1); PG8_STAGE(PG8_SB(0, 0), b2, voffB); PG8_STAGE(PG8_SB(0, 1), b2 + hstepB, voffB); PG8_STAGE(PG8_SA(0, 0), a2, voffA);
            PG8_WAIT_V(8); PG8_WAIT_L(0); PG8_BAR; PG8_MMA(1, 0, At, B0); PG8_MMA(1, 1, At, B1); PG8_BAR; PG8_SCHED;
            PG8_LDB(B0, 1, 0); PG8_LDB(B1, 1, 1); PG8_SCHED; PG8_LDA(At, 1, 0); PG8_STAGE(PG8_SA(0, 1), a2 + hstepA, voffA);
            PG8_WAIT_V(8); PG8_WAIT_L(0); PG8_BAR; PG8_MMA(0, 0, At, B0); PG8_MMA(0, 1, At, B1); PG8_BAR; PG8_SCHED;
            PG8_LDA(At, 1, 1); PG8_STAGE(PG8_SB(1, 0), b3, voffB); PG8_STAGE(PG8_SB(1, 1), b3 + hstepB, voffB); PG8_STAGE(PG8_SA(1, 0), a3, voffA);
            PG8_WAIT_V(8); PG8_WAIT_L(0); PG8_BAR; PG8_MMA(1, 0, At, B0); PG8_MMA(1, 1, At, B1); PG8_BAR; PG8_SCHED;
            } else {
            PG8_LDB(B0, 0, 0); PG8_SCHED; PG8_LDA(At, 0, 0); PG8_STAGE(PG8_SA(1, 1), a1 + hstepA, voffA);
            PG8_WAIT_L(8); PG8_BAR; PG8_WAIT_L(0); PG8_MMA(0, 0, At, B0); PG8_BAR; PG8_SCHED;
            PG8_LDB(B1, 0, 1); PG8_STAGE(PG8_SB(0, 0), b2, voffB);
            PG8_BAR; PG8_WAIT_L(0); PG8_MMA(0, 1, At, B1); PG8_BAR;
            PG8_LDA(At, 0, 1); PG8_STAGE(PG8_SA(0, 0), a2, voffA);
            PG8_BAR; PG8_WAIT_L(0); PG8_MMA(1, 0, At, B0); PG8_BAR; PG8_SCHED;
            PG8_STAGE(PG8_SB(0, 1), b2 + hstepB, voffB);
            PG8_WAIT_V(6); PG8_BAR; PG8_MMA(1, 1, At, B1); PG8_BAR;
            PG8_LDB(B0, 1, 0); PG8_SCHED; PG8_LDA(At, 1, 0); PG8_STAGE(PG8_SA(0, 1), a2 + hstepA, voffA);
            PG8_WAIT_L(8); PG8_BAR; PG8_WAIT_L(0); PG8_MMA(0, 0, At, B0); PG8_BAR; PG8_SCHED;
            PG8_LDB(B1, 1, 1); PG8_STAGE(PG8_SB(1, 0), b3, voffB);
            PG8_BAR; PG8_WAIT_L(0); PG8_MMA(0, 1, At, B1); PG8_BAR;
            PG8_LDA(At, 1, 1); PG8_STAGE(PG8_SA(1, 0), a3, voffA);
            PG8_BAR; PG8_WAIT_L(0); PG8_MMA(1, 0, At, B0); PG8_BAR; PG8_SCHED;
            PG8_STAGE(PG8_SB(1, 1), b3 + hstepB, voffB);
            PG8_WAIT_V(6); PG8_BAR; PG8_MMA(1, 1, At, B1); PG8_BAR;
            }
        }
        if constexpr (ALIGN_EPI) { if (wr == 0) PG8_BAR; }
        if constexpr (!Epi::AFTER_DRAIN) { E(acc, cur, wr, wc, fr, fq); S.done(cur); }
        if (!has_next) break;
#pragma unroll
        for (int a = 0; a < 2; ++a)
#pragma unroll
            for (int b = 0; b < 2; ++b)
#pragma unroll
                for (int m = 0; m < 4; ++m)
#pragma unroll
                    for (int n = 0; n < 2; ++n) acc[a][b][m][n] = (f32x4){0.f, 0.f, 0.f, 0.f};
        cur = nxt; cA = nA; cB = nB; ++ui;
        if constexpr (ALIGN_EPI) { if (wr == 1) PG8_BAR; }
    }
    PG8_WAIT_V(0);
    if constexpr (!ALIGN_EPI) { if (wr == 0) PG8_BAR; }
    PG8_BAR;
    if constexpr (Epi::AFTER_DRAIN) { E.fused(acc, cur, wr, wc, fr, fq, lds, wid, lane); S.done(cur); }
#undef PG8_SA
#undef PG8_SB
#undef PG8_STAGE
#undef PG8_LDA
#undef PG8_LDB
#undef PG8_MMA
#undef PG8_WAIT_V
#undef PG8_WAIT_L
#undef PG8_BAR
#undef PG8_SCHED
}
}
#ifndef PG8_SP2
#define PG8_SP2 true
#endif
#ifndef PG8_ALIGN
#define PG8_ALIGN true
#endif
#define LAS __attribute__((address_space(3)))
typedef unsigned short bf16;
typedef unsigned v4u __attribute__((ext_vector_type(4)));
typedef unsigned v2u __attribute__((ext_vector_type(2)));
typedef float f32x4 __attribute__((ext_vector_type(4)));
typedef short bf16x8 __attribute__((ext_vector_type(8)));

constexpr int NWAVES = 8;
constexpr int BATCH = 2, SEQ = 8192, DM = 1024, M = BATCH * SEQ, NMEM = 256, DFF = 2816, HFF = DFF / 2  , INC = 3080;
constexpr float LOG2E = 1.4426950408889634f;
constexpr float EPS = 1e-6f;

__device__ __forceinline__ unsigned f2bf(float f) { unsigned u = __builtin_bit_cast(unsigned, f); return (u + 0x7fffu + ((u >> 16) & 1u)) >> 16; }
__device__ __forceinline__ unsigned pk2(float lo, float hi) { return f2bf(lo) | (f2bf(hi) << 16); }
__device__ __forceinline__ float bflo(unsigned w) { return __builtin_bit_cast(float, w << 16); }
__device__ __forceinline__ float bfhi(unsigned w) { return __builtin_bit_cast(float, w & 0xffff0000u); }
__device__ __forceinline__ float wave_sum(float v) {
#pragma unroll
    for (int o = 1; o < 64; o <<= 1) v += __shfl_xor(v, o);
    return v;
}
__device__ __forceinline__ float wave_max(float v) {
#pragma unroll
    for (int o = 1; o < 64; o <<= 1) v = fmaxf(v, __shfl_xor(v, o));
    return v;
}

namespace att {
typedef short s16x4 __attribute__((ext_vector_type(4)));
typedef float f32x16 __attribute__((ext_vector_type(16)));
typedef float f32x2_t __attribute__((ext_vector_type(2)));
typedef __bf16 bf16x2_t __attribute__((ext_vector_type(2)));
constexpr int KP = 144, VP = 144;
constexpr int OFF_K = 0, OFF_V = 2 * 64 * KP, OFF_C = OFF_V + 2 * 64 * VP, OFF_F = OFF_C + 512, LDS_BYTES = OFF_F + 64;
constexpr int QKLD = 2048, VTLD = 16384;
__device__ __forceinline__ unsigned cvtpk(float lo, float hi) { f32x2_t v = {lo, hi}; bf16x2_t b = __builtin_convertvector(v, bf16x2_t); return __builtin_bit_cast(unsigned, b); }
__device__ __forceinline__ float ex2(float x) { return __builtin_amdgcn_exp2f(x); }
__device__ __forceinline__ float lg2(float x) { return __builtin_amdgcn_logf(x); }

template <int MODE>
__device__ __forceinline__ void unit(int b, int h, int qb, const bf16* __restrict__ QK, const bf16* __restrict__ VT, const float* __restrict__ C2, bf16* __restrict__ AO, LAS unsigned char* lds) {
    int tid_ = threadIdx.x; asm volatile("" : "+v"(tid_));
    const int tid = tid_, lane = tid & 63, w = __builtin_amdgcn_readfirstlane(tid >> 6), r32 = lane & 31, hi = lane >> 5;
    const int q0 = qb * 256; const size_t rowbase = (size_t)b * SEQ;
    const bf16* Qp = QK + (rowbase + q0 + w * 32 + r32) * QKLD + MODE * 1024 + h * 64;
    const bf16* Kg = QK + rowbase * QKLD + MODE * 1024 + 512 + h * 64;
    const bf16* Vg = VT + (size_t)(MODE * 512 + h * 64) * VTLD + rowbase;
    const float* Cg = C2 + (size_t)(b * 8 + h) * SEQ;
    bf16x8 qr[4];
#pragma unroll
    for (int d0 = 0; d0 < 4; ++d0) qr[d0] = *(const bf16x8*)(Qp + d0 * 16 + hi * 8);
    const int srow = tid >> 3, sch = tid & 7;
    const bf16* kst = Kg + (size_t)srow * QKLD + sch * 8;
    const bf16* vst = Vg + (size_t)srow * VTLD + sch * 8;
    const int NT = 4 * qb + 4, tw = 4 * qb + (w >> 1);
    const int qq = 32 * (w & 1) + r32;
    v4u kreg, vreg; f32x4 creg = {0.f, 0.f, 0.f, 0.f};
    { const int t = NT - 1; kreg = *(const v4u*)(kst + (size_t)t * 64 * QKLD); vreg = *(const v4u*)(vst + t * 64); if (MODE == 0 && tid < 16) creg = *(const f32x4*)(Cg + t * 64 + tid * 4); }
    float cq = 0.f; if (MODE == 0) cq = Cg[q0 + w * 32 + r32];
    float mrun = -1e30f, lsum = 0.f, R = 0.f;
    f32x16 o0, o1;
#pragma unroll
    for (int r = 0; r < 16; ++r) { o0[r] = 0.f; o1[r] = 0.f; }
    LAS unsigned* flags = (LAS unsigned*)(lds + OFF_F);
    for (int it = 0; it < NT; ++it) {
        const int t = NT - 1 - it, bufi = it & 1;
        LAS unsigned char* Kb = lds + OFF_K + bufi * 64 * KP; LAS unsigned char* Vb = lds + OFF_V + bufi * 64 * VP; LAS unsigned char* Cb = lds + OFF_C + bufi * 256;
        *(LAS v4u*)(Kb + srow * KP + sch * 16) = kreg; *(LAS v4u*)(Vb + srow * VP + sch * 16) = vreg;
        if (MODE == 0 && tid < 16) *(LAS f32x4*)(Cb + tid * 16) = creg;
        __syncthreads();
        if (MODE == 1 && it > 0) {
            const v4u fa = *(LAS v4u*)(flags + ((it - 1) & 1) * 8), fb = *(LAS v4u*)(flags + ((it - 1) & 1) * 8 + 4);
            if ((fa.x & fa.y & fa.z & fa.w & fb.x & fb.y & fb.z & fb.w) != 0u) break;
        }
        if (it + 1 < NT) { const int tn = t - 1; kreg = *(const v4u*)(kst + (size_t)tn * 64 * QKLD); vreg = *(const v4u*)(vst + tn * 64); if (MODE == 0 && tid < 16) creg = *(const f32x4*)(Cg + tn * 64 + tid * 4); }
        if (t <= tw) {
            f32x16 p0, p1;
            if (MODE == 0) {
#pragma unroll
                for (int rg = 0; rg < 4; ++rg) { const f32x4 c0 = *(LAS f32x4*)(Cb + (8 * rg + 4 * hi) * 4), c1 = *(LAS f32x4*)(Cb + (32 + 8 * rg + 4 * hi) * 4);
#pragma unroll
                    for (int i = 0; i < 4; ++i) { p0[4 * rg + i] = cq - c0[i]; p1[4 * rg + i] = cq - c1[i]; } }
            } else {
#pragma unroll
                for (int r = 0; r < 16; ++r) { p0[r] = 0.f; p1[r] = 0.f; }
            }
#pragma unroll
            for (int d0 = 0; d0 < 4; ++d0) {
                const bf16x8 a0 = *(LAS bf16x8*)(Kb + r32 * KP + d0 * 32 + hi * 16), a1 = *(LAS bf16x8*)(Kb + (32 + r32) * KP + d0 * 32 + hi * 16);
                p0 = __builtin_amdgcn_mfma_f32_32x32x16_bf16(a0, qr[d0], p0, 0, 0, 0);
                p1 = __builtin_amdgcn_mfma_f32_32x32x16_bf16(a1, qr[d0], p1, 0, 0, 0);
            }
            const bool diag = (t == tw);
            if (MODE == 0) {
                if (diag) {
#pragma unroll
                    for (int r = 0; r < 16; ++r) { const int kk = (r & 3) + 8 * (r >> 2) + 4 * hi; if (kk > qq) p0[r] = -INFINITY; if (kk + 32 > qq) p1[r] = -INFINITY; }
                }
                float rm = fmaxf(p0[0], p1[0]);
#pragma unroll
                for (int r = 1; r < 16; ++r) rm = fmaxf(rm, fmaxf(p0[r], p1[r]));
                rm = fmaxf(rm, __shfl_xor(rm, 32));
                if (__any(rm > mrun)) {
                    const float mn = fmaxf(mrun, rm), al = ex2(mrun - mn);
                    lsum *= al;
#pragma unroll
                    for (int r = 0; r < 16; ++r) { o0[r] *= al; o1[r] *= al; }
                    mrun = mn;
                }
                float s = 0.f;
#pragma unroll
                for (int r = 0; r < 16; ++r) { p0[r] = ex2(p0[r] - mrun); p1[r] = ex2(p1[r] - mrun); s += p0[r] + p1[r]; }
                lsum += s;
            } else {
                f32x16 x0, x1;
#pragma unroll
                for (int r = 0; r < 16; ++r) {
                    x0[r] = p0[r] > 24.f ? p0[r] : lg2(1.f + ex2(p0[r]));
                    x1[r] = p1[r] > 24.f ? p1[r] : lg2(1.f + ex2(p1[r]));
                }
                if (diag) {
#pragma unroll
                    for (int r = 0; r < 16; ++r) { const int kk = (r & 3) + 8 * (r >> 2) + 4 * hi; if (kk >= qq) x0[r] = 0.f; if (kk + 32 >= qq) x1[r] = 0.f; }
                }
                float gs[8], ps[8], aft[8];
#pragma unroll
                for (int rg = 0; rg < 4; ++rg) { gs[rg] = (x0[4 * rg] + x0[4 * rg + 1]) + (x0[4 * rg + 2] + x0[4 * rg + 3]); gs[4 + rg] = (x1[4 * rg] + x1[4 * rg + 1]) + (x1[4 * rg + 2] + x1[4 * rg + 3]); }
#pragma unroll
                for (int i = 0; i < 8; ++i) ps[i] = __shfl_xor(gs[i], 32);
                float run = 0.f;
#pragma unroll
                for (int i = 7; i >= 0; --i) { aft[i] = run + (hi ? 0.f : ps[i]); run += gs[i] + ps[i]; }
#pragma unroll
                for (int rg = 0; rg < 4; ++rg) {
                    float bs = R + aft[rg];
                    x0[4 * rg + 3] += bs; x0[4 * rg + 2] += x0[4 * rg + 3]; x0[4 * rg + 1] += x0[4 * rg + 2]; x0[4 * rg] += x0[4 * rg + 1];
                    bs = R + aft[4 + rg];
                    x1[4 * rg + 3] += bs; x1[4 * rg + 2] += x1[4 * rg + 3]; x1[4 * rg + 1] += x1[4 * rg + 2]; x1[4 * rg] += x1[4 * rg + 1];
                }
                R += run;
#pragma unroll
                for (int r = 0; r < 16; ++r) { p0[r] = ex2(p0[r] - x0[r]); p1[r] = ex2(p1[r] - x1[r]); }
                if (diag) {
#pragma unroll
                    for (int r = 0; r < 16; ++r) { const int kk = (r & 3) + 8 * (r >> 2) + 4 * hi; if (kk >= qq) p0[r] = 0.f; if (kk + 32 >= qq) p1[r] = 0.f; }
                }
            }
            v4u pw[4];
#pragma unroll
            for (int j = 0; j < 2; ++j) {
                pw[j]     = (v4u){cvtpk(p0[8 * j], p0[8 * j + 1]), cvtpk(p0[8 * j + 2], p0[8 * j + 3]), cvtpk(p0[8 * j + 4], p0[8 * j + 5]), cvtpk(p0[8 * j + 6], p0[8 * j + 7])};
                pw[2 + j] = (v4u){cvtpk(p1[8 * j], p1[8 * j + 1]), cvtpk(p1[8 * j + 2], p1[8 * j + 3]), cvtpk(p1[8 * j + 4], p1[8 * j + 5]), cvtpk(p1[8 * j + 6], p1[8 * j + 7])};
            }
#pragma unroll
            for (int ks = 0; ks < 4; ++ks) {
                const bf16x8 pa = __builtin_bit_cast(bf16x8, pw[ks]);
                const s16x4 l0 = *(LAS s16x4*)(Vb + r32 * VP + (16 * ks + 4 * hi) * 2), h0 = *(LAS s16x4*)(Vb + r32 * VP + (16 * ks + 8 + 4 * hi) * 2);
                const s16x4 l1 = *(LAS s16x4*)(Vb + (32 + r32) * VP + (16 * ks + 4 * hi) * 2), h1 = *(LAS s16x4*)(Vb + (32 + r32) * VP + (16 * ks + 8 + 4 * hi) * 2);
                const bf16x8 v0 = (bf16x8){l0[0], l0[1], l0[2], l0[3], h0[0], h0[1], h0[2], h0[3]};
                const bf16x8 v1 = (bf16x8){l1[0], l1[1], l1[2], l1[3], h1[0], h1[1], h1[2], h1[3]};
                o0 = __builtin_amdgcn_mfma_f32_32x32x16_bf16(v0, pa, o0, 0, 0, 0);
                o1 = __builtin_amdgcn_mfma_f32_32x32x16_bf16(v1, pa, o1, 0, 0, 0);
            }
        }
        if (MODE == 1) { const bool done = __all(R > 150.f); if (lane == 0) flags[bufi * 8 + w] = done ? 1u : 0u; }
    }
    float inv = 1.f;
    if (MODE == 0) { const float lt = lsum + __shfl_xor(lsum, 32); inv = 1.f / lt; }
    bf16* Op = AO + (rowbase + q0 + w * 32 + r32) * 1024 + MODE * 512 + h * 64 + 4 * hi;
#pragma unroll
    for (int rg = 0; rg < 4; ++rg) {
        v2u a, c;
        a.x = cvtpk(o0[4 * rg] * inv, o0[4 * rg + 1] * inv); a.y = cvtpk(o0[4 * rg + 2] * inv, o0[4 * rg + 3] * inv);
        c.x = cvtpk(o1[4 * rg] * inv, o1[4 * rg + 1] * inv); c.y = cvtpk(o1[4 * rg + 2] * inv, o1[4 * rg + 3] * inv);
        *(v2u*)(Op + 8 * rg) = a; *(v2u*)(Op + 32 + 8 * rg) = c;
    }
    __syncthreads();
}
}
constexpr size_t MiB = 1u << 20;
constexpr size_t WS_WQK = 1 * MiB, WS_WV = 5 * MiB, WS_WOUT = 7 * MiB, WS_WMQN = 9 * MiB, WS_WMKV = 11 * MiB, WS_WMO = 15 * MiB, WS_WUP = 17 * MiB, WS_WDOWN = 28 * MiB;
constexpr size_t WS_MN = 34 * MiB, WS_KVM = 35 * MiB, WS_WK = 37 * MiB, WS_VW = 41 * MiB, WS_LF = 45 * MiB, WS_C2 = 46 * MiB;
constexpr size_t WS_H = 48 * MiB, WS_QK = 80 * MiB, WS_VT = 144 * MiB, WS_AO = 176 * MiB;
constexpr size_t WS_S = 80 * MiB, WS_P = 144 * MiB, WS_U = 80 * MiB, WS_ACT = 168 * MiB, WS_END = 256 * MiB;
static_assert(WS_U + (size_t)M * DFF * 2 <= WS_ACT && WS_ACT + (size_t)M * DFF * 2 <= WS_END, "d_ws map");

constexpr int LDS_BYTES = 147456;
constexpr int NSTEPS = 16;

struct Args { const float* in[19]; float* out; unsigned char* ws; int ph_lo, ph_hi; };

struct Ctx {
    LAS unsigned char* lds;
    int tid, lane, wave, vcu, G;
    float* out; unsigned char* ws;
};
constexpr int PARAM_OFF = 131072;
__device__ __forceinline__ const float* inp(const Ctx& F, int k) {
    volatile LAS unsigned* p = (volatile LAS unsigned*)(F.lds + PARAM_OFF) + 2 * k;
    const unsigned lo = __builtin_amdgcn_readfirstlane(p[0]), hi = __builtin_amdgcn_readfirstlane(p[1]);
    return (const float*)(((unsigned long long)hi << 32) | (unsigned long long)lo);
}

__device__ __forceinline__ void transpose_item(const float* __restrict__ W, int ldw, int c0, int ncols, bf16* __restrict__ WT, int ldt, int row_off, float scale, LAS float* scr, int item, int lane) {
    const int nblk = ncols / 32, kb = item / nblk, nb = item % nblk, k0 = 64 * kb, n0 = 32 * nb;
#pragma unroll
    for (int i = 0; i < 32; ++i) { const int kk = 2 * i + (lane >> 5); scr[kk * 33 + (lane & 31)] = W[(size_t)(k0 + kk) * ldw + c0 + n0 + (lane & 31)] * scale; }
    asm volatile("s_waitcnt lgkmcnt(0)" ::: "memory");
    const int c = lane & 7;
#pragma unroll
    for (int j = 0; j < 4; ++j) { const int n = (lane >> 3) + 8 * j; const LAS float* s = scr + (8 * c) * 33 + n;
        v4u o; o.x = pk2(s[0 * 33], s[1 * 33]); o.y = pk2(s[2 * 33], s[3 * 33]); o.z = pk2(s[4 * 33], s[5 * 33]); o.w = pk2(s[6 * 33], s[7 * 33]);
        *(v4u*)(WT + (size_t)(row_off + n0 + n) * ldt + k0 + 8 * c) = o; }
    asm volatile("s_waitcnt lgkmcnt(0)" ::: "memory");
}

__device__ __forceinline__ void rms_row_to_bf16(const float* __restrict__ xrow, const float* __restrict__ g, bf16* __restrict__ orow, int lane, f32x4 (&v)[4]) {
    const f32x4* xr = (const f32x4*)xrow + lane; const f32x4* gr = (const f32x4*)g + lane;
    float s2 = 0.f;
#pragma unroll
    for (int j = 0; j < 4; ++j) { v[j] = xr[64 * j]; s2 += (v[j].x * v[j].x + v[j].y * v[j].y) + (v[j].z * v[j].z + v[j].w * v[j].w); }
    const float rstd = 1.0f / sqrtf(wave_sum(s2) * (1.f / DM) + EPS);
    unsigned long long* o8 = (unsigned long long*)orow + lane;
#pragma unroll
    for (int j = 0; j < 4; ++j) { const f32x4 gg = gr[64 * j]; v[j] = v[j] * rstd * gg;
        o8[64 * j] = (unsigned long long)pk2(v[j].x, v[j].y) | ((unsigned long long)pk2(v[j].z, v[j].w) << 32); }
}

__device__ __forceinline__ float log_sigmoid(float x) { return fminf(x, 0.f) - log1pf(expf(-fabsf(x))); }

__device__ __forceinline__ void step_prologue(const Ctx& F) {
    LAS float* scr = (LAS float*)(F.lds + F.wave * 16384);
    const int gw = F.vcu * NWAVES + F.wave, NGW = F.G * NWAVES;
    unsigned char* ws = F.ws;
    const float* w_in = inp(F, 3);
    const float QS = 0.125f * LOG2E;
    constexpr int I_IN = 16 * 16, I_OUT = 16 * 32, I_MKV = 16 * 64, I_MO = 16 * 32, I_UP = 16 * 44, I_DN = 44 * 32;
    constexpr int NITEMS = 6 * I_IN + I_OUT + I_MKV + I_MO + 4 * I_UP + I_DN;
    for (int it = gw; it < NITEMS; it += NGW) {
        int r = it;
        if (r < 6 * I_IN) { const int blk = r / I_IN; r -= blk * I_IN;
            bf16* dst = (blk == 2 || blk == 5) ? (bf16*)(ws + WS_WV) : (bf16*)(ws + WS_WQK);
            const int row_off = (blk == 0) ? 0 : (blk == 1) ? 512 : (blk == 2) ? 0 : (blk == 3) ? 1024 : (blk == 4) ? 1536 : 512;
            const float sc = (blk == 0 || blk == 3) ? QS : 1.f;
            transpose_item(w_in, INC, blk * 512, 512, dst, DM, row_off, sc, scr, r, F.lane); continue; }
        r -= 6 * I_IN;
        if (r < I_OUT) { transpose_item(inp(F, 7), DM, 0, DM, (bf16*)(ws + WS_WOUT), DM, 0, 1.f, scr, r, F.lane); continue; } r -= I_OUT;
        if (r < I_MKV) { transpose_item(inp(F, 11), 2 * DM, 0, 2 * DM, (bf16*)(ws + WS_WMKV), DM, 0, 1.f, scr, r, F.lane); continue; } r -= I_MKV;
        if (r < I_MO) { transpose_item(inp(F, 12), DM, 0, DM, (bf16*)(ws + WS_WMO), DM, 0, 1.f, scr, r, F.lane); continue; } r -= I_MO;
        if (r < 4 * I_UP) { const int blk = r / I_UP; r -= blk * I_UP;
            const int c0 = (blk == 0) ? 0 : (blk == 1) ? DFF : (blk == 2) ? HFF : DFF + HFF;
            transpose_item(inp(F, 14), 2 * DFF, c0, HFF, (bf16*)(ws + WS_WUP), DM, blk * HFF, 1.f, scr, r, F.lane); continue; }
        r -= 4 * I_UP;
        transpose_item(inp(F, 17), DM, 0, DM, (bf16*)(ws + WS_WDOWN), DFF, 0, 1.f, scr, r, F.lane);
    }
    { const float* wq = inp(F, 10); bf16* dq = (bf16*)(ws + WS_WMQN); const float sc = 0.0625f * LOG2E;
      for (int i = (F.vcu * 512 + F.tid); i < DM * DM / 4; i += F.G * 512) { const f32x4 v = ((const f32x4*)wq)[i]; v2u o; o.x = pk2(v.x * sc, v.y * sc); o.y = pk2(v.z * sc, v.w * sc); ((v2u*)dq)[i] = o; } }
    { const float* x = inp(F, 0); const float* g = inp(F, 2); const float* bfg = inp(F, 4); bf16* H = (bf16*)(ws + WS_H); float* LF = (float*)(ws + WS_LF);
      LAS float* wf = (LAS float*)F.lds;
      __syncthreads();
#pragma unroll
      for (int kk = 0; kk < 2; ++kk) { const int k = F.tid + 512 * kk; const f32x4 wa = *(const f32x4*)(w_in + (size_t)k * INC + 3072), wb = *(const f32x4*)(w_in + (size_t)k * INC + 3076);
          wf[k] = wa.x; wf[1024 + k] = wa.y; wf[2048 + k] = wa.z; wf[3072 + k] = wa.w; wf[4096 + k] = wb.x; wf[5120 + k] = wb.y; wf[6144 + k] = wb.z; wf[7168 + k] = wb.w; }
      __syncthreads();
      for (int m = gw; m < M; m += NGW) {
          f32x4 v[4]; rms_row_to_bf16(x + (size_t)m * DM, g, H + (size_t)m * DM, F.lane, v);
          float acc[8];
#pragma unroll
          for (int j8 = 0; j8 < 8; ++j8) { float a = 0.f;
#pragma unroll
              for (int j = 0; j < 4; ++j) { const f32x4 wv = *(LAS f32x4*)(wf + j8 * 1024 + 4 * F.lane + 256 * j); a += (v[j].x * wv.x + v[j].y * wv.y) + (v[j].z * wv.z + v[j].w * wv.w); }
              acc[j8] = wave_sum(a); }
          if (F.lane < 8) { float a = acc[0];
#pragma unroll
              for (int j = 1; j < 8; ++j) a = (F.lane == j) ? acc[j] : a;
              const int bb = m / SEQ, s = m % SEQ; LF[(size_t)(bb * 8 + F.lane) * SEQ + s] = log_sigmoid(a + bfg[F.lane]); }
      } }
    { const float* mem = inp(F, 1); const float* g = inp(F, 9); bf16* MN = (bf16*)(ws + WS_MN);
      for (int m = gw; m < BATCH * NMEM; m += NGW) { f32x4 v[4]; rms_row_to_bf16(mem + (size_t)m * DM, g, MN + (size_t)m * DM, F.lane, v); } }
}

__device__ __forceinline__ void step_scan(const Ctx& F) {
    if (blockIdx.x >= 16) return;
    const int seq = blockIdx.x;
    const size_t off = (size_t)seq * SEQ + F.wave * 1024 + F.lane * 16;
    const float* src = (const float*)(F.ws + WS_LF) + off; float* dst = (float*)(F.ws + WS_C2) + off;
    float v[16];
#pragma unroll
    for (int i = 0; i < 4; ++i) { const f32x4 t = ((const f32x4*)src)[i]; v[4 * i] = t.x; v[4 * i + 1] = t.y; v[4 * i + 2] = t.z; v[4 * i + 3] = t.w; }
#pragma unroll
    for (int i = 1; i < 16; ++i) v[i] += v[i - 1];
    const float tot = v[15]; float inc = tot;
#pragma unroll
    for (int o = 1; o < 64; o <<= 1) { const float u = __shfl_up(inc, o); if (F.lane >= o) inc += u; }
    LAS float* wt = (LAS float*)(F.lds + 65536);
    if (F.lane == 63) wt[F.wave] = inc;
    __syncthreads();
    float pre = inc - tot;
    for (int w2 = 0; w2 < F.wave; ++w2) pre += wt[w2];
#pragma unroll
    for (int i = 0; i < 4; ++i) { f32x4 o; o.x = (pre + v[4 * i]) * LOG2E; o.y = (pre + v[4 * i + 1]) * LOG2E; o.z = (pre + v[4 * i + 2]) * LOG2E; o.w = (pre + v[4 * i + 3]) * LOG2E; ((f32x4*)dst)[i] = o; }
}

__device__ __forceinline__ void step_mixnorm(const Ctx& F) {
    const int gw = F.vcu * NWAVES + F.wave, NGW = F.G * NWAVES; bf16* AO = (bf16*)(F.ws + WS_AO);
    const float* gf = inp(F, 5); const float* gs = inp(F, 6);
    for (int m = gw; m < M; m += NGW) {
        v4u* row = (v4u*)(AO + (size_t)m * DM) + F.lane;
#pragma unroll
        for (int hf = 0; hf < 2; ++hf) {
            const v4u w = row[64 * hf]; float v[8];
            v[0] = bflo(w.x); v[1] = bfhi(w.x); v[2] = bflo(w.y); v[3] = bfhi(w.y); v[4] = bflo(w.z); v[5] = bfhi(w.z); v[6] = bflo(w.w); v[7] = bfhi(w.w);
            float s2 = 0.f;
#pragma unroll
            for (int e = 0; e < 8; ++e) s2 += v[e] * v[e];
            const float rstd = 1.0f / sqrtf(wave_sum(s2) * (1.f / 512.f) + EPS);
            const float* g = (hf ? gs : gf) + 8 * F.lane; const f32x4 ga = *(const f32x4*)g, gb = *(const f32x4*)(g + 4);
            v4u o; o.x = pk2(v[0] * rstd * ga.x, v[1] * rstd * ga.y); o.y = pk2(v[2] * rstd * ga.z, v[3] * rstd * ga.w); o.z = pk2(v[4] * rstd * gb.x, v[5] * rstd * gb.y); o.w = pk2(v[6] * rstd * gb.z, v[7] * rstd * gb.w);
            row[64 * hf] = o;
        }
    }
}

__device__ __forceinline__ void step_rms(const Ctx& F, const float* g) {
    const int gw = F.vcu * NWAVES + F.wave, NGW = F.G * NWAVES; bf16* H = (bf16*)(F.ws + WS_H);
    for (int m = gw; m < M; m += NGW) { f32x4 v[4]; rms_row_to_bf16(F.out + (size_t)m * DM, g, H + (size_t)m * DM, F.lane, v); }
}

__device__ __forceinline__ void step_final(const Ctx& F) {
    const int gw = F.vcu * NWAVES + F.wave, NGW = F.G * NWAVES; const float* g = inp(F, 18);
    for (int m = gw; m < M; m += NGW) {
        f32x4* xr = (f32x4*)(F.out + (size_t)m * DM) + F.lane; const f32x4* gr = (const f32x4*)g + F.lane; f32x4 v[4]; float s2 = 0.f;
#pragma unroll
        for (int j = 0; j < 4; ++j) { v[j] = xr[64 * j]; s2 += (v[j].x * v[j].x + v[j].y * v[j].y) + (v[j].z * v[j].z + v[j].w * v[j].w); }
        const float rstd = 1.0f / sqrtf(wave_sum(s2) * (1.f / DM) + EPS);
#pragma unroll
        for (int j = 0; j < 4; ++j) xr[64 * j] = v[j] * rstd * gr[64 * j];
    }
}

__device__ __forceinline__ void step_memsoftmax(const Ctx& F) {
    const int gw = F.vcu * NWAVES + F.wave, NGW = F.G * NWAVES; const float* S = (const float*)(F.ws + WS_S); bf16* P = (bf16*)(F.ws + WS_P);
    for (int m = gw; m < M; m += NGW) {
        const f32x4* sr = (const f32x4*)(S + (size_t)m * DM) + F.lane; unsigned long long* o8 = (unsigned long long*)(P + (size_t)m * DM) + F.lane;
#pragma unroll
        for (int j = 0; j < 4; ++j) { f32x4 v = sr[64 * j];
            const float mx = wave_max(fmaxf(fmaxf(v.x, v.y), fmaxf(v.z, v.w)));
            v.x = att::ex2(v.x - mx); v.y = att::ex2(v.y - mx); v.z = att::ex2(v.z - mx); v.w = att::ex2(v.w - mx);
            const float inv = 1.f / wave_sum((v.x + v.y) + (v.z + v.w));
            o8[64 * j] = (unsigned long long)pk2(v.x * inv, v.y * inv) | ((unsigned long long)pk2(v.z * inv, v.w * inv) << 32); }
    }
}

__device__ __forceinline__ void unpack8(const v4u a, float (&o)[8]) { o[0] = bflo(a.x); o[1] = bfhi(a.x); o[2] = bflo(a.y); o[3] = bfhi(a.y); o[4] = bflo(a.z); o[5] = bfhi(a.z); o[6] = bflo(a.w); o[7] = bfhi(a.w); }
__device__ __forceinline__ void step_conv(const Ctx& F, int half) {
    const bf16* U = (const bf16*)(F.ws + WS_U); bf16* ACT = (bf16*)(F.ws + WS_ACT); const float* cw = inp(F, 15); const float* cb = inp(F, 16);
    constexpr int NCC = HFF / 8  , NRC = M / 8, NIT = NCC * NRC;
    for (int item = F.vcu * 512 + F.tid; item < NIT; item += F.G * 512) {
        const int cc = item % NCC, rc = item / NCC, t0 = rc * 8, j0 = cc * 8, fg = half * HFF + j0, fv = DFF + fg;
        const bool first = (t0 % SEQ) == 0;
        v4u ug[10], uv[10];
#pragma unroll
        for (int rr = 0; rr < 10; ++rr) {
            if (rr < 2 && first) { ug[rr] = (v4u){0u, 0u, 0u, 0u}; uv[rr] = (v4u){0u, 0u, 0u, 0u}; }
            else { const size_t t = (size_t)(t0 - 2 + rr); ug[rr] = *(const v4u*)(U + t * DFF + j0); uv[rr] = *(const v4u*)(U + t * DFF + HFF + j0); }
        }
        float wg[3][8], wv[3][8], bg[8], bv[8];
#pragma unroll
        for (int i = 0; i < 3; ++i)
#pragma unroll
            for (int e = 0; e < 8; e += 4) { const f32x4 a = *(const f32x4*)(cw + (size_t)i * 2 * DFF + fg + e), c = *(const f32x4*)(cw + (size_t)i * 2 * DFF + fv + e);
                wg[i][e] = a.x; wg[i][e + 1] = a.y; wg[i][e + 2] = a.z; wg[i][e + 3] = a.w; wv[i][e] = c.x; wv[i][e + 1] = c.y; wv[i][e + 2] = c.z; wv[i][e + 3] = c.w; }
#pragma unroll
        for (int e = 0; e < 8; e += 4) { const f32x4 a = *(const f32x4*)(cb + fg + e), c = *(const f32x4*)(cb + fv + e);
            bg[e] = a.x; bg[e + 1] = a.y; bg[e + 2] = a.z; bg[e + 3] = a.w; bv[e] = c.x; bv[e + 1] = c.y; bv[e + 2] = c.z; bv[e + 3] = c.w; }
        float g2[8], g1[8], v2[8], v1[8];
        unpack8(ug[0], g2); unpack8(ug[1], g1); unpack8(uv[0], v2); unpack8(uv[1], v1);
#pragma unroll
        for (int rr = 0; rr < 8; ++rr) {
            float g0[8], v0[8], o[8];
            unpack8(ug[rr + 2], g0); unpack8(uv[rr + 2], v0);
#pragma unroll
            for (int e = 0; e < 8; ++e) {
                const float gt = bg[e] + wg[0][e] * g2[e] + wg[1][e] * g1[e] + wg[2][e] * g0[e];
                const float vl = bv[e] + wv[0][e] * v2[e] + wv[1][e] * v1[e] + wv[2][e] * v0[e];
                o[e] = gt / (1.f + __expf(-gt)) * vl;
                g2[e] = g1[e]; g1[e] = g0[e]; v2[e] = v1[e]; v1[e] = v0[e];
            }
            v4u ov; ov.x = pk2(o[0], o[1]); ov.y = pk2(o[2], o[3]); ov.z = pk2(o[4], o[5]); ov.w = pk2(o[6], o[7]);
            *(v4u*)(ACT + (size_t)(t0 + rr) * DFF + fg) = ov;
        }
    }
}

__device__ __forceinline__ void step_attention(const Ctx& F) {
    const bf16* QK = (const bf16*)(F.ws + WS_QK); const bf16* VT = (const bf16*)(F.ws + WS_VT); const float* C2 = (const float*)(F.ws + WS_C2); bf16* AO = (bf16*)(F.ws + WS_AO);
#pragma nounroll
    for (int id = F.vcu; id < 512; id += F.G) { const int v = id & 255, bh = v >> 4, s = v & 15, qb = (id >> 8) ? 31 - s : s; att::unit<0>(bh >> 3, bh & 7, qb, QK, VT, C2, AO, F.lds); }
#pragma nounroll
    for (int id = F.vcu; id < 512; id += F.G) { const int v = id & 255, bh = v >> 4, s = v & 15, qb = (id >> 8) ? 31 - s : s; att::unit<1>(bh >> 3, bh & 7, qb, QK, VT, C2, AO, F.lds); }
}

struct Job { pg8::Gemm g; int G, c; bf16* O; int ldc; const float* base; float* out; };

__device__ __forceinline__ bool bf16_job(const Ctx& F, int step, int j, Job& J) {
    unsigned char* ws = F.ws; const int bx = (int)blockIdx.x;
    J.G = F.G; J.c = bx; J.base = nullptr; J.out = nullptr;
    if (step == 1) {
        if (j == 0) { J.g = pg8::Gemm{(const bf16*)(ws + WS_H), (const bf16*)(ws + WS_WQK), M, 2048, DM, DM, DM}; J.O = (bf16*)(ws + WS_QK); J.ldc = 2048; return true; }
        if (j == 1) { J.g = pg8::Gemm{(const bf16*)(ws + WS_WV), (const bf16*)(ws + WS_H), DM, M, DM, DM, DM}; J.O = (bf16*)(ws + WS_VT); J.ldc = M; return true; }
        if (j == 2) { J.g = pg8::Gemm{(const bf16*)(ws + WS_MN), (const bf16*)(ws + WS_WMKV), BATCH * NMEM, 2 * DM, DM, DM, DM}; J.O = (bf16*)(ws + WS_KVM); J.ldc = 2 * DM; return true; }
        return false;
    }
    if (step == 3) {
        if (j != 0 || bx >= 64) return false;
        const int ci = bx >> 2, kind = ci >> 3, bb = (ci >> 2) & 1, hh = ci & 3; J.G = 4; J.c = bx & 3;
        const bf16* KVM = (const bf16*)(ws + WS_KVM);
        if (kind == 0) {
            J.g = pg8::Gemm{KVM + (size_t)(bb * NMEM) * 2048 + hh * 256, (const bf16*)(ws + WS_WMQN) + hh * 256, 256, DM, 256, 2048, DM};
            J.O = (bf16*)(ws + WS_WK) + (size_t)(bb * DM + hh * 256) * DM; J.ldc = DM;
        } else {
            J.g = pg8::Gemm{(const bf16*)(ws + WS_WMO) + hh * 256, KVM + (size_t)(bb * NMEM) * 2048 + DM + hh * 256, DM, 256, 256, DM, 2048};
            J.O = (bf16*)(ws + WS_VW) + (size_t)bb * DM * DM + hh * 256; J.ldc = DM;
        }
        return true;
    }
    if (step == 10 || step == 12) {
        if (j != 0) return false;
        const int half = (step == 12);
        J.g = pg8::Gemm{(const bf16*)(ws + WS_H), (const bf16*)(ws + WS_WUP) + (size_t)half * DFF * DM, M, DFF, DM, DM, DM}; J.O = (bf16*)(ws + WS_U); J.ldc = DFF; return true;
    }
    return false;
}
__device__ __forceinline__ bool f32_job(const Ctx& F, int step, Job& J) {
    unsigned char* ws = F.ws; const int bx = (int)blockIdx.x;
    J.G = F.G; J.c = bx; J.O = nullptr;
    if (step == 4) { J.g = pg8::Gemm{(const bf16*)(ws + WS_AO), (const bf16*)(ws + WS_WOUT), M, DM, DM, DM, DM}; J.base = inp(F, 0); J.out = F.out; J.ldc = DM; return true; }
    if (step == 6 || step == 8) {
        const int bb = bx & 1; J.G = F.G >> 1; J.c = bx >> 1;
        if ((F.G & 1) && bx == F.G - 1) return false;
        if (step == 6) { J.g = pg8::Gemm{(const bf16*)(ws + WS_H) + (size_t)bb * SEQ * DM, (const bf16*)(ws + WS_WK) + (size_t)bb * DM * DM, SEQ, DM, DM, DM, DM}; J.base = nullptr; J.out = (float*)(ws + WS_S) + (size_t)bb * SEQ * DM; }
        else           { J.g = pg8::Gemm{(const bf16*)(ws + WS_P) + (size_t)bb * SEQ * DM, (const bf16*)(ws + WS_VW) + (size_t)bb * DM * DM, SEQ, DM, DM, DM, DM}; J.out = F.out + (size_t)bb * SEQ * DM; J.base = J.out; }
        J.ldc = DM; return true;
    }
    if (step == 14) { J.g = pg8::Gemm{(const bf16*)(ws + WS_ACT), (const bf16*)(ws + WS_WDOWN), M, DM, DFF, DFF, DFF}; J.base = F.out; J.out = F.out; J.ldc = DM; return true; }
    return false;
}

__global__ void __launch_bounds__(NWAVES * 64, 2) fwd_kernel(Args args) {
    extern __shared__ __attribute__((aligned(16))) unsigned char lds[];
    cg::grid_group grid = cg::this_grid();
    Ctx F0;
    F0.lds = (LAS unsigned char*)lds; F0.tid = threadIdx.x; F0.lane = F0.tid & 63; F0.wave = __builtin_amdgcn_readfirstlane(F0.tid >> 6);
    F0.G = gridDim.x; { const int bx = blockIdx.x; F0.vcu = (F0.G % 8 == 0) ? (bx % 8) * (F0.G / 8) + bx / 8 : bx; }
    F0.out = args.out; F0.ws = args.ws;
    if (F0.tid == 0) { LAS unsigned long long* pl = (LAS unsigned long long*)(F0.lds + PARAM_OFF);
#pragma unroll
        for (int i = 0; i < 19; ++i) pl[i] = (unsigned long long)args.in[i]; }
    __syncthreads();
    const int lo = args.ph_lo, hi = args.ph_hi;
#pragma nounroll
    for (int si = lo; si < hi; ++si) {
#if defined(PROBE_REP)
        const int step = si <= PROBE_REP ? si : si - 1;
#else
        const int step = si;
#endif
        Ctx F = F0;
        asm volatile("" : "+v"(F.tid)); F.lane = F.tid & 63; F.wave = __builtin_amdgcn_readfirstlane(F.tid >> 6);
        asm volatile("" : "+s"(F.vcu), "+s"(F.G), "+s"(F.ws), "+s"(F.out));
        switch (step) {
            case 0: step_prologue(F); break;
            case 1: step_scan(F); break;
            case 2: step_attention(F); break;
            case 3: step_mixnorm(F); break;
            case 5: step_rms(F, inp(F, 8)); break;
            case 7: step_memsoftmax(F); break;
            case 9: step_rms(F, inp(F, 13)); break;
            case 11: step_conv(F, 0); break;
            case 13: step_conv(F, 1); break;
            case 15: step_final(F); break;
            default: break;
        }
        __syncthreads();
#pragma nounroll
        for (int j = 0; j < 3; ++j) {
            Job J;
            if (!bf16_job(F, step, j, J)) break;
            pg8::StaticOrder S; S.init(J.g.M, J.g.N, J.G, J.c);
            pg8::EpiBf16<0> E{J.O, J.ldc, nullptr, 0, 0, 1.f};
            pg8::gemm_phase<pg8::EpiBf16<0>, pg8::StaticOrder, PG8_ALIGN, PG8_SP2>(F.lds, J.g, S, E);
            __syncthreads();
        }
        {
            Job J;
            if (f32_job(F, step, J)) {
                pg8::StaticOrder S; S.init(J.g.M, J.g.N, J.G, J.c);
                pg8::EpiResF32 E{J.base, J.out, J.ldc};
                pg8::gemm_phase<pg8::EpiResF32, pg8::StaticOrder, PG8_ALIGN, PG8_SP2>(F.lds, J.g, S, E);
                __syncthreads();
            }
        }
        if (si + 1 < hi) grid.sync();
    }
}

#ifndef MK_PER_STEP
#define MK_PER_STEP 0
#endif
extern "C" void kernel_launch(void* const* d_in, const int* in_sizes, int n_in, void* d_out, int out_size, void* d_ws, size_t ws_size, hipStream_t stream) {
    static int grid = 0;
    if (grid == 0) {
        if (n_in != 19 || in_sizes[0] != M * DM || out_size != M * DM || ws_size < WS_END) { fprintf(stderr, "kernel_launch: unexpected shapes (n_in %d, in0 %d, out %d, ws %zu)\n", n_in, n_in > 0 ? in_sizes[0] : -1, out_size, ws_size); grid = -1; return; }
        int dev = 0, cus = 0, per_cu = 0;
        if (hipGetDevice(&dev) != hipSuccess || hipDeviceGetAttribute(&cus, hipDeviceAttributeMultiprocessorCount, dev) != hipSuccess) { grid = -1; return; }
        if (hipFuncSetAttribute((const void*)fwd_kernel, hipFuncAttributeMaxDynamicSharedMemorySize, LDS_BYTES) != hipSuccess) { fprintf(stderr, "kernel_launch: hipFuncSetAttribute failed\n"); grid = -1; return; }
        if (hipOccupancyMaxActiveBlocksPerMultiprocessor(&per_cu, (const void*)fwd_kernel, NWAVES * 64, LDS_BYTES) != hipSuccess || per_cu < 1) { fprintf(stderr, "kernel_launch: occupancy query says %d\n", per_cu); per_cu = 1; }
        (void)hipGetLastError();
        grid = cus;
    }
    if (grid < 0) return;
    Args a{};
    for (int i = 0; i < 19; ++i) a.in[i] = (const float*)d_in[i];
    a.out = (float*)d_out; a.ws = (unsigned char*)d_ws;
#if MK_PER_STEP
    for (int s = 0; s < NSTEPS; ++s) { a.ph_lo = s; a.ph_hi = s + 1; hipLaunchKernelGGL(fwd_kernel, dim3(grid), dim3(NWAVES * 64), LDS_BYTES, stream, a); }
#else
#if defined(PROBE_REP)
    a.ph_lo = 0; a.ph_hi = NSTEPS + 1;
#else
    a.ph_lo = 0; a.ph_hi = NSTEPS;
#endif
    void* kargs[] = {&a};
    const hipError_t e = hipLaunchCooperativeKernel((const void*)fwd_kernel, dim3(grid), dim3(NWAVES * 64), kargs, LDS_BYTES, stream);
    if (e != hipSuccess) fprintf(stderr, "kernel_launch: cooperative launch failed: %s (grid %d)\n", hipGetErrorString(e), grid);
#endif
}
```

```cpp
#include <hip/hip_runtime.h>
#include <hip/hip_cooperative_groups.h>
#include <cstdio>
#include <cstdint>
namespace cg = cooperative_groups;
namespace pg8 {
#define PG8_LAS __attribute__((address_space(3)))
typedef unsigned short bf16_t;
typedef short bf16x8 __attribute__((ext_vector_type(8)));
typedef float f32x4 __attribute__((ext_vector_type(4)));
typedef unsigned u32x4 __attribute__((ext_vector_type(4)));
constexpr int BM = 256, BK = 64, HALF = 128, HTB = HALF * BK * 2  , STAGE_BYTES = 8 * HTB, NXCD = 8, WGM = 8;

__host__ __device__ __forceinline__ int lds_byte(int r, int c) { const int st = (r >> 4) * 2 + (c >> 5), rr = r & 15, cc = c & 31, ob = rr * 64 + cc * 2; return st * 1024 + (ob ^ (((ob >> 9) & 1) << 5)); }
__host__ __device__ __forceinline__ void stage_rc(int b, int& R, int& C) { const int st = b / 1024, sb = b % 1024, swz = sb ^ (((sb >> 9) & 1) << 5); R = (st >> 1) * 16 + swz / 64; C = (st & 1) * 32 + (swz % 64) / 2; }
__host__ __device__ __forceinline__ int perm32(int rho) { const int n = rho >> 4, i = rho & 15; return 8 * (i >> 2) + 4 * n + (i & 3); }

struct Unit { int pm, pn; };
struct Gemm { const bf16_t* A; const bf16_t* Bt; int M, N, K, lda, ldb; };

struct StaticOrder {
    int nM, nN, nwg, G, c;
    __host__ __device__ void init(int M, int N, int G_, int c_) { nM = M / BM; nN = N / BM; nwg = nM * nN; G = G_; c = c_; }
    __host__ __device__ bool next(int i, Unit& u) const {
        const long L = (long)i * G + c; if (L >= nwg) return false;
        int wgid = (int)L; { const int q = nwg / NXCD, r = nwg % NXCD, xcd = wgid % NXCD, off = wgid / NXCD; wgid = (xcd < r ? xcd * (q + 1) : r * (q + 1) + (xcd - r) * q) + off; }
        const int nig = WGM * nN, gid = wgid / nig, fm = gid * WGM, gsz = (nM - fm) < WGM ? (nM - fm) : WGM;
        u.pm = fm + ((wgid % nig) % gsz); u.pn = (wgid % nig) / gsz; return true;
    }
    __device__ __forceinline__ void a_ready(const Unit&) const {}
    __device__ __forceinline__ void done(const Unit&) const {}
};

__device__ __forceinline__ unsigned cvt_pk_bf16(float lo, float hi) { unsigned r; asm volatile("v_cvt_pk_bf16_f32 %0, %1, %2" : "=v"(r) : "v"(lo), "v"(hi)); return r; }
typedef float f32x2 __attribute__((ext_vector_type(2)));
__device__ __forceinline__ f32x2 gelu_pk(f32x2 v) {
    const f32x2 av = __builtin_elementwise_abs(v), d = av * 0.2316418882f + 1.0f;
    f32x2 t; t.x = __builtin_amdgcn_rcpf(d.x); t.y = __builtin_amdgcn_rcpf(d.y);
    f32x2 q = t * 0.5307027145f + (-0.7265760135f); q = q * t + 0.7107068705f; q = q * t + (-0.142248368f); q = q * t + 0.127414796f; q = q * t;
    const f32x2 s = (v * v) * (-0.72134752044f);
    f32x2 e; e.x = __builtin_amdgcn_exp2f(s.x); e.y = __builtin_amdgcn_exp2f(s.y);
    const f32x2 m = v * (q * e), r = v - m;
    f32x2 o; o.x = v.x < 0.f ? m.x : r.x; o.y = v.y < 0.f ? m.y : r.y; return o;
}

__device__ __forceinline__ float row_rstd(const float* ps, size_t r) {
    const f32x4 a = *(const f32x4*)(ps + r * 16), b = *(const f32x4*)(ps + r * 16 + 4), c = *(const f32x4*)(ps + r * 16 + 8), d = *(const f32x4*)(ps + r * 16 + 12);
    const float s = (((a[0] + a[1]) + (a[2] + a[3])) + ((b[0] + b[1]) + (b[2] + b[3]))) + (((c[0] + c[1]) + (c[2] + c[3])) + ((d[0] + d[1]) + (d[2] + d[3])));
    return 1.0f / sqrtf(s * (1.0f / 1024.0f) + 1e-6f);
}
struct EpiBf16 {
    static constexpr bool PERM = true, AFTER_DRAIN = false;
    bf16_t* O; int ldc; const float* ps;
    __device__ __forceinline__ void operator()(const f32x4 (&acc)[2][2][4][2], const Unit& u, int wr, int wc, int fr, int fq) const {
        const int row0 = u.pm * BM + wr * 64 + fr, col0 = u.pn * BM + wc * 32 + 8 * fq;
#pragma unroll
        for (int ai = 0; ai < 2; ++ai)
#pragma unroll
            for (int m = 0; m < 4; ++m) { const size_t r = (size_t)(row0 + ai * HALF + m * 16); bf16_t* rowp = O + r * ldc + col0;
                const float rs = ps ? row_rstd(ps, r) : 1.0f;
#pragma unroll
                for (int bj = 0; bj < 2; ++bj) { const f32x4 v0 = acc[ai][bj][m][0] * rs, v1 = acc[ai][bj][m][1] * rs;
                    u32x4 w; w.x = cvt_pk_bf16(v0[0], v0[1]); w.y = cvt_pk_bf16(v0[2], v0[3]); w.z = cvt_pk_bf16(v1[0], v1[1]); w.w = cvt_pk_bf16(v1[2], v1[3]);
                    *(u32x4*)(rowp + bj * HALF) = w; } }
    }
};
struct EpiResF32 {
    static constexpr bool PERM = false, AFTER_DRAIN = false;
    const float* base; float* out; int ldc; bf16_t* hn; const float* gn; float* ps_out;
    __device__ __forceinline__ void operator()(const f32x4 (&acc)[2][2][4][2], const Unit& u, int wr, int wc, int fr, int fq) const {
        const int col0 = u.pn * BM + wc * 32 + 4 * fq;
        f32x4 gv[2][2];
#pragma unroll
        for (int bj = 0; bj < 2; ++bj)
#pragma unroll
            for (int n = 0; n < 2; ++n) gv[bj][n] = hn ? *(const f32x4*)(gn + col0 + bj * HALF + n * 16) : (f32x4){0.f, 0.f, 0.f, 0.f};
#pragma unroll
        for (int ai = 0; ai < 2; ++ai)
#pragma unroll
            for (int m = 0; m < 4; ++m) { const size_t r = (size_t)(u.pm * BM + ai * HALF + wr * 64 + m * 16 + fr), off = r * ldc + col0; float ss = 0.f;
#pragma unroll
                for (int bj = 0; bj < 2; ++bj)
#pragma unroll
                    for (int n = 0; n < 2; ++n) { f32x4 v = acc[ai][bj][m][n]; if (base) v += *(const f32x4*)(base + off + bj * HALF + n * 16); *(f32x4*)(out + off + bj * HALF + n * 16) = v;
                        if (hn) { ss += (v[0] * v[0] + v[1] * v[1]) + (v[2] * v[2] + v[3] * v[3]); const f32x4 w = v * gv[bj][n];
                            typedef unsigned u32x2 __attribute__((ext_vector_type(2))); u32x2 p; p.x = cvt_pk_bf16(w[0], w[1]); p.y = cvt_pk_bf16(w[2], w[3]); *(u32x2*)(hn + off + bj * HALF + n * 16) = p; } }
                if (hn) { ss += __shfl_xor(ss, 16); ss += __shfl_xor(ss, 32); if (fq == 0) ps_out[r * 16 + u.pn * 4 + wc] = ss; } }
    }
};
struct EpiSoftmax {
    static constexpr bool PERM = false, AFTER_DRAIN = true;
    const float* ps; bf16_t* P; int ldc;
    __device__ __forceinline__ void fused(f32x4 (&acc)[2][2][4][2], const Unit& u, int wr, int wc, int fr, int fq, PG8_LAS unsigned char* lds, int wid, int lane) const {
        PG8_LAS float* T = (PG8_LAS float*)lds;
        PG8_LAS float* T2 = T + 1024;
        const int col0 = u.pn * BM + wc * 32 + 4 * fq;
#pragma unroll
        for (int ai = 0; ai < 2; ++ai)
#pragma unroll
            for (int m = 0; m < 4; ++m) { const int rl = ai * HALF + wr * 64 + m * 16 + fr; const float rs = row_rstd(ps, (size_t)(u.pm * BM + rl)); float mx = -3.0e38f;
#pragma unroll
                for (int bj = 0; bj < 2; ++bj)
#pragma unroll
                    for (int n = 0; n < 2; ++n) { f32x4 v = acc[ai][bj][m][n] * rs; acc[ai][bj][m][n] = v; mx = fmaxf(fmaxf(mx, fmaxf(v[0], v[1])), fmaxf(v[2], v[3])); }
                mx = fmaxf(mx, __shfl_xor(mx, 16)); mx = fmaxf(mx, __shfl_xor(mx, 32));
                if (fq == 0) T[rl * 4 + wc] = mx; }
        asm volatile("s_waitcnt lgkmcnt(0)" ::: "memory"); __builtin_amdgcn_s_barrier(); asm volatile("" ::: "memory");
#pragma unroll
        for (int ai = 0; ai < 2; ++ai)
#pragma unroll
            for (int m = 0; m < 4; ++m) { const int rl = ai * HALF + wr * 64 + m * 16 + fr; const f32x4 t = *(const PG8_LAS f32x4*)(T + rl * 4); const float mx = fmaxf(fmaxf(t[0], t[1]), fmaxf(t[2], t[3])); float s = 0.f;
#pragma unroll
                for (int bj = 0; bj < 2; ++bj)
#pragma unroll
                    for (int n = 0; n < 2; ++n) { f32x4 v = acc[ai][bj][m][n]; v[0] = __builtin_amdgcn_exp2f(v[0] - mx); v[1] = __builtin_amdgcn_exp2f(v[1] - mx); v[2] = __builtin_amdgcn_exp2f(v[2] - mx); v[3] = __builtin_amdgcn_exp2f(v[3] - mx);
                        acc[ai][bj][m][n] = v; s += (v[0] + v[1]) + (v[2] + v[3]); }
                s += __shfl_xor(s, 16); s += __shfl_xor(s, 32);
                if (fq == 0) T2[rl * 4 + wc] = s; }
        asm volatile("s_waitcnt lgkmcnt(0)" ::: "memory"); __builtin_amdgcn_s_barrier(); asm volatile("" ::: "memory");
#pragma unroll
        for (int ai = 0; ai < 2; ++ai)
#pragma unroll
            for (int m = 0; m < 4; ++m) { const int rl = ai * HALF + wr * 64 + m * 16 + fr; const f32x4 t = *(const PG8_LAS f32x4*)(T2 + rl * 4); const float inv = 1.0f / ((t[0] + t[1]) + (t[2] + t[3]));
                bf16_t* rowp = P + (size_t)(u.pm * BM + rl) * ldc + col0;
#pragma unroll
                for (int bj = 0; bj < 2; ++bj)
#pragma unroll
                    for (int n = 0; n < 2; ++n) { const f32x4 v = acc[ai][bj][m][n] * inv; typedef unsigned u32x2 __attribute__((ext_vector_type(2))); u32x2 p; p.x = cvt_pk_bf16(v[0], v[1]); p.y = cvt_pk_bf16(v[2], v[3]); *(u32x2*)(rowp + bj * HALF + n * 16) = p; } }
        asm volatile("s_waitcnt lgkmcnt(0)" ::: "memory"); __builtin_amdgcn_s_barrier(); asm volatile("" ::: "memory");
    }
};
template <class Epi, class Sched, bool ALIGN_EPI = false, bool SP2 = false>
__device__ __forceinline__ void gemm_phase(PG8_LAS unsigned char* lds, const Gemm g, const Sched& S, const Epi& E) {
    int tid_ = threadIdx.x; asm volatile("" : "+v"(tid_));
    const int tid = tid_, wid = __builtin_amdgcn_readfirstlane(tid >> 6), lane = tid & 63, wr = wid >> 2, wc = wid & 3, fr = lane & 15, fq = lane >> 4;
    const int K = g.K, nt = K / BK;
    unsigned voffA[2], voffB[2];
#pragma unroll
    for (int i = 0; i < 2; ++i) { int R, C; stage_rc(tid * 16 + i * 8192, R, C); const int Rb = Epi::PERM ? ((R & ~31) + perm32(R & 31)) : R;
        voffA[i] = (unsigned)(R * g.lda + C) * 2u; voffB[i] = (unsigned)(Rb * g.ldb + C) * 2u; }
    const size_t kstep = (size_t)(BK * 2);
    const size_t hstepA = (size_t)HALF * g.lda * 2, hstepB = (size_t)HALF * g.ldb * 2;
    const size_t tstepA = 2 * hstepA, tstepB = 2 * hstepB;
    const unsigned ldsw = (unsigned)wid * 1024u;
    const int aoff = lds_byte(wr * 64 + fr, fq * 8), boff = lds_byte(wc * 32 + fr, fq * 8);
#define PG8_SA(b, h) (((b) * 2 + (h)) * HTB)
#define PG8_SB(b, h) ((4 + (b) * 2 + (h)) * HTB)
#define PG8_STAGE(bufoff, gbase, voff) do { _Pragma("unroll") for (int _i = 0; _i < 2; ++_i) \
        __builtin_amdgcn_global_load_lds((const unsigned*)((const char*)(gbase) + (voff)[_i]), (PG8_LAS unsigned*)(lds + (bufoff) + ldsw + _i * 8192), 16, 0, 0); } while (0)
#define PG8_LDA(dst, b, h) do { _Pragma("unroll") for (int m = 0; m < 4; ++m) _Pragma("unroll") for (int k = 0; k < 2; ++k) dst[m][k] = *(const PG8_LAS bf16x8*)(lds + PG8_SA(b, h) + aoff + m * 2048 + k * 1024); } while (0)
#define PG8_LDB(dst, b, h) do { _Pragma("unroll") for (int n = 0; n < 2; ++n) _Pragma("unroll") for (int k = 0; k < 2; ++k) dst[n][k] = *(const PG8_LAS bf16x8*)(lds + PG8_SB(b, h) + boff + n * 2048 + k * 1024); } while (0)
#define PG8_MMA(ai, bj, At, Bt) do { __builtin_amdgcn_s_setprio(1); _Pragma("unroll") for (int m = 0; m < 4; ++m) _Pragma("unroll") for (int n = 0; n < 2; ++n) _Pragma("unroll") for (int k = 0; k < 2; ++k) \
        acc[ai][bj][m][n] = __builtin_amdgcn_mfma_f32_16x16x32_bf16(Bt[n][k], At[m][k], acc[ai][bj][m][n], 0, 0, 0); __builtin_amdgcn_s_setprio(0); } while (0)
#define PG8_WAIT_V(n) asm volatile("s_waitcnt vmcnt(" #n ")" ::: "memory")
#define PG8_WAIT_L(n) asm volatile("s_waitcnt lgkmcnt(" #n ")" ::: "memory")
#define PG8_BAR __builtin_amdgcn_s_barrier()
#define PG8_SCHED __builtin_amdgcn_sched_barrier(0)
    Unit cur, nxt; int ui = 0;
    if (!S.next(0, cur)) return;
    f32x4 acc[2][2][4][2];
#pragma unroll
    for (int a = 0; a < 2; ++a)
#pragma unroll
        for (int b = 0; b < 2; ++b)
#pragma unroll
            for (int m = 0; m < 4; ++m)
#pragma unroll
                for (int n = 0; n < 2; ++n) acc[a][b][m][n] = (f32x4){0.f, 0.f, 0.f, 0.f};
    bf16x8 At[4][2], B0[2][2], B1[2][2];
    const char* cA = (const char*)g.A + (size_t)cur.pm * tstepA; const char* cB = (const char*)g.Bt + (size_t)cur.pn * tstepB;
    S.a_ready(cur);
    if constexpr (SP2) {
        PG8_STAGE(PG8_SB(0, 0), cB, voffB); PG8_STAGE(PG8_SB(0, 1), cB + hstepB, voffB); PG8_STAGE(PG8_SA(0, 0), cA, voffA); PG8_STAGE(PG8_SA(0, 1), cA + hstepA, voffA);
        if (wr == 1) PG8_BAR;
        PG8_WAIT_V(2); PG8_BAR;
        PG8_STAGE(PG8_SB(1, 0), cB + kstep, voffB); PG8_STAGE(PG8_SA(1, 0), cA + kstep, voffA); PG8_STAGE(PG8_SB(1, 1), cB + hstepB + kstep, voffB);
        PG8_WAIT_V(6); PG8_BAR;
    } else {
        PG8_STAGE(PG8_SB(0, 0), cB, voffB); PG8_STAGE(PG8_SA(0, 0), cA, voffA); PG8_STAGE(PG8_SB(0, 1), cB + hstepB, voffB); PG8_STAGE(PG8_SA(0, 1), cA + hstepA, voffA);
        if (wr == 1) PG8_BAR;
        PG8_WAIT_V(4); PG8_BAR;
        PG8_STAGE(PG8_SB(1, 0), cB + kstep, voffB); PG8_STAGE(PG8_SA(1, 0), cA + kstep, voffA); PG8_STAGE(PG8_SB(1, 1), cB + hstepB + kstep, voffB);
        PG8_WAIT_V(6); PG8_BAR;
    }
    for (;;) {
        const bool has_next = S.next(ui + 1, nxt);
        const char* nA = has_next ? (const char*)g.A + (size_t)nxt.pm * tstepA : cA; const char* nB = has_next ? (const char*)g.Bt + (size_t)nxt.pn * tstepB : cB;
        for (int t = 0; t < nt; t += 2) {
            const bool last = (t == nt - 2);
            const char* a1 = cA + (size_t)(t + 1) * kstep;
            const char* a2 = last ? nA : cA + (size_t)(t + 2) * kstep; const char* b2 = last ? nB : cB + (size_t)(t + 2) * kstep;
            const char* a3 = a2 + kstep; const char* b3 = b2 + kstep;
            if (last && has_next) S.a_ready(nxt);
            if constexpr (SP2) {
            PG8_LDB(B0, 0, 0); PG8_LDB(B1, 0, 1); PG8_SCHED; PG8_LDA(At, 0, 0); PG8_STAGE(PG8_SA(1, 1), a1 + hstepA, voffA);
            PG8_WAIT_V(8); PG8_WAIT_L(0); PG8_BAR; PG8_MMA(0, 0, At, B0); PG8_MMA(0, 1, At, B1); PG8_BAR; PG8_SCHED;
            PG8_LDA(At, 0, 1); PG8_STAGE(PG8_SB(0, 0), b2, voffB); PG8_STAGE(PG8_SB(0, 1), b2 + hstepB, voffB); PG8_STAGE(PG8_SA(0, 0), a2, voffA);
            PG8_WAIT_V(8); PG8_WAIT_L(0); PG8_BAR; PG8_MMA(1, 0, At, B0); PG8_MMA(1, 1, At, B1); PG8_BAR; PG8_SCHED;
            PG8_LDB(B0, 1, 0); PG8_LDB(B1, 1, 1); PG8_SCHED; PG8_LDA(At, 1, 0); PG8_STAGE(PG8_SA(0, 1), a2 + hstepA, voffA);
            PG8_WAIT_V(8); PG8_WAIT_L(0); PG8_BAR; PG8_MMA(0, 0, At, B0); PG8_MMA(0, 1, At, B1); PG8_BAR; PG8_SCHED;
            PG8_LDA(At, 1, 1); PG8_STAGE(PG8_SB(1, 0), b3, voffB); PG8_STAGE(PG8_SB(1, 1), b3 + hstepB, voffB); PG8_STAGE(PG8_SA(1, 0), a3, voffA);
            PG8_WAIT_V(8); PG8_WAIT_L(0); PG8_BAR; PG8_MMA(1, 0, At, B0); PG8_MMA(1, 1, At, B1); PG8_BAR; PG8_SCHED;
            } else {
            PG8_LDB(B0, 0, 0); PG8_SCHED; PG8_LDA(At, 0, 0); PG8_STAGE(PG8_SA(1, 1), a1 + hstepA, voffA);
            PG8_WAIT_L(8); PG8_BAR; PG8_WAIT_L(0); PG8_MMA(0, 0, At, B0); PG8_BAR; PG8_SCHED;
            PG8_LDB(B1, 0, 1); PG8_STAGE(PG8_SB(0, 0), b2, voffB);
            PG8_BAR; PG8_WAIT_L(0); PG8_MMA(0, 1, At, B1); PG8_BAR;
            PG8_LDA(At, 0, 1); PG8_STAGE(PG8_SA(0, 0), a2, voffA);
            PG8_BAR; PG8_WAIT_L(0); PG8_MMA(1, 0, At, B0); PG8_BAR; PG8_SCHED;
            PG8_STAGE(PG8_SB(0, 1), b2 + hstepB, voffB);
            PG8_WAIT_V(6); PG8_BAR; PG8_MMA(1, 1, At, B1); PG8_BAR;
            PG8_LDB(B0, 1, 0); PG8_SCHED; PG8_LDA(At, 1, 0); PG8_STAGE(PG8_SA(0, 1), a2 + hstepA, voffA);
            PG8_WAIT_L(8); PG8_BAR; PG8_WAIT_L(0); PG8_MMA(0, 0, At, B0); PG8_BAR; PG8_SCHED;
            PG8_LDB(B1, 1, 1); PG8_STAGE(PG8_SB(1, 0), b3, voffB);
            PG8_BAR; PG8_WAIT_L(0); PG8_MMA(0, 1, At, B1); PG8_BAR;
            PG8_LDA(At, 1, 1); PG8_STAGE(PG8_SA(1, 0), a3, voffA);
            PG8_BAR; PG8_WAIT_L(0); PG8_MMA(1, 0, At, B0); PG8_BAR; PG8_SCHED;
            PG8_STAGE(PG8_SB(1, 1), b3 + hstepB, voffB);
            PG8_WAIT_V(6); PG8_BAR; PG8_MMA(1, 1, At, B1); PG8_BAR;
            }
        }
        if constexpr (ALIGN_EPI) { if (wr == 0) PG8_BAR; }
        if constexpr (!Epi::AFTER_DRAIN) { E(acc, cur, wr, wc, fr, fq); S.done(cur); }
        if (!has_next) break;
#pragma unroll
        for (int a = 0; a < 2; ++a)
#pragma unroll
            for (int b = 0; b < 2; ++b)
#pragma unroll
                for (int m = 0; m < 4; ++m)
#pragma unroll
                    for (int n = 0; n < 2; ++n) acc[a][b][m][n] = (f32x4){0.f, 0.f, 0.f, 0.f};
        cur = nxt; cA = nA; cB = nB; ++ui;
        if constexpr (ALIGN_EPI) { if (wr == 1) PG8_BAR; }
    }
    PG8_WAIT_V(0);
    if constexpr (!ALIGN_EPI) { if (wr == 0) PG8_BAR; }
    PG8_BAR;
    if constexpr (Epi::AFTER_DRAIN) { E.fused(acc, cur, wr, wc, fr, fq, lds, wid, lane); S.done(cur); }
#undef PG8_SA
#undef PG8_SB
#undef PG8_STAGE
#undef PG8_LDA
#undef PG8_LDB
#undef PG8_MMA
#undef PG8_WAIT_V
#undef PG8_WAIT_L
#undef PG8_BAR
#undef PG8_SCHED
}
}
#ifndef PG8_SP2
#define PG8_SP2 true
#endif
#ifndef PG8_ALIGN
#define PG8_ALIGN true
#endif
#define LAS __attribute__((address_space(3)))
typedef unsigned short bf16;
typedef unsigned v4u __attribute__((ext_vector_type(4)));
typedef unsigned v2u __attribute__((ext_vector_type(2)));
typedef float f32x4 __attribute__((ext_vector_type(4)));
typedef short bf16x8 __attribute__((ext_vector_type(8)));

constexpr int NWAVES = 8;
constexpr int BATCH = 2, SEQ = 8192, DM = 1024, M = BATCH * SEQ, NMEM = 256, DFF = 2816, HFF = DFF / 2  , INC = 3080;
constexpr float LOG2E = 1.4426950408889634f;
constexpr float EPS = 1e-6f;

__device__ __forceinline__ unsigned f2bf(float f) { unsigned u = __builtin_bit_cast(unsigned, f); return (u + 0x7fffu + ((u >> 16) & 1u)) >> 16; }
__device__ __forceinline__ unsigned pk2(float lo, float hi) { return f2bf(lo) | (f2bf(hi) << 16); }
__device__ __forceinline__ float bflo(unsigned w) { return __builtin_bit_cast(float, w << 16); }
__device__ __forceinline__ float bfhi(unsigned w) { return __builtin_bit_cast(float, w & 0xffff0000u); }
__device__ __forceinline__ float wave_sum(float v) {
#pragma unroll
    for (int o = 1; o < 64; o <<= 1) v += __shfl_xor(v, o);
    return v;
}
__device__ __forceinline__ float wave_max(float v) {
#pragma unroll
    for (int o = 1; o < 64; o <<= 1) v = fmaxf(v, __shfl_xor(v, o));
    return v;
}

namespace att {
typedef short s16x4 __attribute__((ext_vector_type(4)));
typedef float f32x16 __attribute__((ext_vector_type(16)));
typedef float f32x2_t __attribute__((ext_vector_type(2)));
typedef __bf16 bf16x2_t __attribute__((ext_vector_type(2)));
constexpr int KP = 144, VP = 144;
constexpr int OFF_K = 0, OFF_V = 2 * 64 * KP, OFF_C = OFF_V + 2 * 64 * VP, OFF_F = OFF_C + 512, LDS_BYTES = OFF_F + 64;
constexpr int QKLD = 2048, VTLD = 16384;
__device__ __forceinline__ unsigned cvtpk(float lo, float hi) { f32x2_t v = {lo, hi}; bf16x2_t b = __builtin_convertvector(v, bf16x2_t); return __builtin_bit_cast(unsigned, b); }
__device__ __forceinline__ float ex2(float x) { return __builtin_amdgcn_exp2f(x); }
__device__ __forceinline__ float lg2(float x) { return __builtin_amdgcn_logf(x); }

template <int MODE>
__device__ __forceinline__ void unit(int b, int h, int qb, const bf16* __restrict__ QK, const bf16* __restrict__ VT, const float* __restrict__ C2, bf16* __restrict__ AO, LAS unsigned char* lds) {
    int tid_ = threadIdx.x; asm volatile("" : "+v"(tid_));
    const int tid = tid_, lane = tid & 63, w = __builtin_amdgcn_readfirstlane(tid >> 6), r32 = lane & 31, hi = lane >> 5;
    const int q0 = qb * 256; const size_t rowbase = (size_t)b * SEQ;
    const bf16* Qp = QK + (rowbase + q0 + w * 32 + r32) * QKLD + MODE * 1024 + h * 64;
    const bf16* Kg = QK + rowbase * QKLD + MODE * 1024 + 512 + h * 64;
    const bf16* Vg = VT + (size_t)(MODE * 512 + h * 64) * VTLD + rowbase;
    const float* Cg = C2 + (size_t)(b * 8 + h) * SEQ;
    bf16x8 qr[4];
#pragma unroll
    for (int d0 = 0; d0 < 4; ++d0) qr[d0] = *(const bf16x8*)(Qp + d0 * 16 + hi * 8);
    const int srow = tid >> 3, sch = tid & 7;
    const bf16* kst = Kg + (size_t)srow * QKLD + sch * 8;
    const bf16* vst = Vg + (size_t)srow * VTLD + sch * 8;
    const int NT = 4 * qb + 4, tw = 4 * qb + (w >> 1);
    const int qq = 32 * (w & 1) + r32;
    v4u kreg, vreg; f32x4 creg = {0.f, 0.f, 0.f, 0.f};
    { const int t = NT - 1; kreg = *(const v4u*)(kst + (size_t)t * 64 * QKLD); vreg = *(const v4u*)(vst + t * 64); if (MODE == 0 && tid < 16) creg = *(const f32x4*)(Cg + t * 64 + tid * 4); }
    float cq = 0.f; if (MODE == 0) cq = Cg[q0 + w * 32 + r32];
    float mrun = -1e30f, lsum = 0.f, R = 0.f;
    f32x16 o0, o1;
#pragma unroll
    for (int r = 0; r < 16; ++r) { o0[r] = 0.f; o1[r] = 0.f; }
    LAS unsigned* flags = (LAS unsigned*)(lds + OFF_F);
    for (int it = 0; it < NT; ++it) {
        const int t = NT - 1 - it, bufi = it & 1;
        LAS unsigned char* Kb = lds + OFF_K + bufi * 64 * KP; LAS unsigned char* Vb = lds + OFF_V + bufi * 64 * VP; LAS unsigned char* Cb = lds + OFF_C + bufi * 256;
        *(LAS v4u*)(Kb + srow * KP + sch * 16) = kreg; *(LAS v4u*)(Vb + srow * VP + sch * 16) = vreg;
        if (MODE == 0 && tid < 16) *(LAS f32x4*)(Cb + tid * 16) = creg;
        __syncthreads();
        if (MODE == 1 && it > 0) {
            const v4u fa = *(LAS v4u*)(flags + ((it - 1) & 1) * 8), fb = *(LAS v4u*)(flags + ((it - 1) & 1) * 8 + 4);
            if ((fa.x & fa.y & fa.z & fa.w & fb.x & fb.y & fb.z & fb.w) != 0u) break;
        }
        if (it + 1 < NT) { const int tn = t - 1; kreg = *(const v4u*)(kst + (size_t)tn * 64 * QKLD); vreg = *(const v4u*)(vst + tn * 64); if (MODE == 0 && tid < 16) creg = *(const f32x4*)(Cg + tn * 64 + tid * 4); }
        if (t <= tw) {
            f32x16 p0, p1;
            if (MODE == 0) {
#pragma unroll
                for (int rg = 0; rg < 4; ++rg) { const f32x4 c0 = *(LAS f32x4*)(Cb + (8 * rg + 4 * hi) * 4), c1 = *(LAS f32x4*)(Cb + (32 + 8 * rg + 4 * hi) * 4);
#pragma unroll
                    for (int i = 0; i < 4; ++i) { p0[4 * rg + i] = cq - c0[i]; p1[4 * rg + i] = cq - c1[i]; } }
            } else {
#pragma unroll
                for (int r = 0; r < 16; ++r) { p0[r] = 0.f; p1[r] = 0.f; }
            }
#pragma unroll
            for (int d0 = 0; d0 < 4; ++d0) {
                const bf16x8 a0 = *(LAS bf16x8*)(Kb + r32 * KP + d0 * 32 + hi * 16), a1 = *(LAS bf16x8*)(Kb + (32 + r32) * KP + d0 * 32 + hi * 16);
                p0 = __builtin_amdgcn_mfma_f32_32x32x16_bf16(a0, qr[d0], p0, 0, 0, 0);
                p1 = __builtin_amdgcn_mfma_f32_32x32x16_bf16(a1, qr[d0], p1, 0, 0, 0);
            }
            const bool diag = (t == tw);
            if (MODE == 0) {
                if (diag) {
#pragma unroll
                    for (int r = 0; r < 16; ++r) { const int kk = (r & 3) + 8 * (r >> 2) + 4 * hi; if (kk > qq) p0[r] = -INFINITY; if (kk + 32 > qq) p1[r] = -INFINITY; }
                }
                float rm = fmaxf(p0[0], p1[0]);
#pragma unroll
                for (int r = 1; r < 16; ++r) rm = fmaxf(rm, fmaxf(p0[r], p1[r]));
                rm = fmaxf(rm, __shfl_xor(rm, 32));
                if (__any(rm > mrun)) {
                    const float mn = fmaxf(mrun, rm), al = ex2(mrun - mn);
                    lsum *= al;
#pragma unroll
                    for (int r = 0; r < 16; ++r) { o0[r] *= al; o1[r] *= al; }
                    mrun = mn;
                }
                float s = 0.f;
#pragma unroll
                for (int r = 0; r < 16; ++r) { p0[r] = ex2(p0[r] - mrun); p1[r] = ex2(p1[r] - mrun); s += p0[r] + p1[r]; }
                lsum += s;
            } else {
                f32x16 x0, x1;
#pragma unroll
                for (int r = 0; r < 16; ++r) {
                    x0[r] = p0[r] > 24.f ? p0[r] : lg2(1.f + ex2(p0[r]));
                    x1[r] = p1[r] > 24.f ? p1[r] : lg2(1.f + ex2(p1[r]));
                }
                if (diag) {
#pragma unroll
                    for (int r = 0; r < 16; ++r) { const int kk = (r & 3) + 8 * (r >> 2) + 4 * hi; if (kk >= qq) x0[r] = 0.f; if (kk + 32 >= qq) x1[r] = 0.f; }
                }
                float gs[8], ps[8], aft[8];
#pragma unroll
                for (int rg = 0; rg < 4; ++rg) { gs[rg] = (x0[4 * rg] + x0[4 * rg + 1]) + (x0[4 * rg + 2] + x0[4 * rg + 3]); gs[4 + rg] = (x1[4 * rg] + x1[4 * rg + 1]) + (x1[4 * rg + 2] + x1[4 * rg + 3]); }
#pragma unroll
                for (int i = 0; i < 8; ++i) ps[i] = __shfl_xor(gs[i], 32);
                float run = 0.f;
#pragma unroll
                for (int i = 7; i >= 0; --i) { aft[i] = run + (hi ? 0.f : ps[i]); run += gs[i] + ps[i]; }
#pragma unroll
                for (int rg = 0; rg < 4; ++rg) {
                    float bs = R + aft[rg];
                    x0[4 * rg + 3] += bs; x0[4 * rg + 2] += x0[4 * rg + 3]; x0[4 * rg + 1] += x0[4 * rg + 2]; x0[4 * rg] += x0[4 * rg + 1];
                    bs = R + aft[4 + rg];
                    x1[4 * rg + 3] += bs; x1[4 * rg + 2] += x1[4 * rg + 3]; x1[4 * rg + 1] += x1[4 * rg + 2]; x1[4 * rg] += x1[4 * rg + 1];
                }
                R += run;
#pragma unroll
                for (int r = 0; r < 16; ++r) { p0[r] = ex2(p0[r] - x0[r]); p1[r] = ex2(p1[r] - x1[r]); }
                if (diag) {
#pragma unroll
                    for (int r = 0; r < 16; ++r) { const int kk = (r & 3) + 8 * (r >> 2) + 4 * hi; if (kk >= qq) p0[r] = 0.f; if (kk + 32 >= qq) p1[r] = 0.f; }
                }
            }
            v4u pw[4];
#pragma unroll
            for (int j = 0; j < 2; ++j) {
                pw[j]     = (v4u){cvtpk(p0[8 * j], p0[8 * j + 1]), cvtpk(p0[8 * j + 2], p0[8 * j + 3]), cvtpk(p0[8 * j + 4], p0[8 * j + 5]), cvtpk(p0[8 * j + 6], p0[8 * j + 7])};
                pw[2 + j] = (v4u){cvtpk(p1[8 * j], p1[8 * j + 1]), cvtpk(p1[8 * j + 2], p1[8 * j + 3]), cvtpk(p1[8 * j + 4], p1[8 * j + 5]), cvtpk(p1[8 * j + 6], p1[8 * j + 7])};
            }
#pragma unroll
            for (int ks = 0; ks < 4; ++ks) {
                const bf16x8 pa = __builtin_bit_cast(bf16x8, pw[ks]);
                const s16x4 l0 = *(LAS s16x4*)(Vb + r32 * VP + (16 * ks + 4 * hi) * 2), h0 = *(LAS s16x4*)(Vb + r32 * VP + (16 * ks + 8 + 4 * hi) * 2);
                const s16x4 l1 = *(LAS s16x4*)(Vb + (32 + r32) * VP + (16 * ks + 4 * hi) * 2), h1 = *(LAS s16x4*)(Vb + (32 + r32) * VP + (16 * ks + 8 + 4 * hi) * 2);
                const bf16x8 v0 = (bf16x8){l0[0], l0[1], l0[2], l0[3], h0[0], h0[1], h0[2], h0[3]};
                const bf16x8 v1 = (bf16x8){l1[0], l1[1], l1[2], l1[3], h1[0], h1[1], h1[2], h1[3]};
                o0 = __builtin_amdgcn_mfma_f32_32x32x16_bf16(v0, pa, o0, 0, 0, 0);
                o1 = __builtin_amdgcn_mfma_f32_32x32x16_bf16(v1, pa, o1, 0, 0, 0);
            }
        }
        if (MODE == 1) { const bool done = __all(R > 150.f); if (lane == 0) flags[bufi * 8 + w] = done ? 1u : 0u; }
    }
    float inv = 1.f;
    if (MODE == 0) { const float lt = lsum + __shfl_xor(lsum, 32); inv = 1.f / lt; }
    bf16* Op = AO + (rowbase + q0 + w * 32 + r32) * 1024 + MODE * 512 + h * 64 + 4 * hi;
#pragma unroll
    for (int rg = 0; rg < 4; ++rg) {
        v2u a, c;
        a.x = cvtpk(o0[4 * rg] * inv, o0[4 * rg + 1] * inv); a.y = cvtpk(o0[4 * rg + 2] * inv, o0[4 * rg + 3] * inv);
        c.x = cvtpk(o1[4 * rg] * inv, o1[4 * rg + 1] * inv); c.y = cvtpk(o1[4 * rg + 2] * inv, o1[4 * rg + 3] * inv);
        *(v2u*)(Op + 8 * rg) = a; *(v2u*)(Op + 32 + 8 * rg) = c;
    }
    __syncthreads();
}
}
constexpr size_t MiB = 1u << 20;
constexpr size_t WS_WQK = 1 * MiB, WS_WV = 5 * MiB, WS_WOUT = 7 * MiB, WS_WMQN = 9 * MiB, WS_WMKV = 11 * MiB, WS_WMO = 15 * MiB, WS_WUP = 17 * MiB, WS_WDOWN = 28 * MiB;
constexpr size_t WS_MN = 34 * MiB, WS_KVM = 35 * MiB, WS_WK = 37 * MiB, WS_VW = 41 * MiB, WS_LF = 45 * MiB, WS_C2 = 46 * MiB, WS_PS = 47 * MiB;
constexpr size_t WS_H = 48 * MiB, WS_QK = 80 * MiB, WS_VT = 144 * MiB, WS_AO = 176 * MiB;
constexpr size_t WS_S = 80 * MiB, WS_P = 144 * MiB, WS_U = 80 * MiB, WS_ACT = 168 * MiB, WS_END = 256 * MiB;
static_assert(WS_U + (size_t)M * DFF * 2 <= WS_ACT && WS_ACT + (size_t)M * DFF * 2 <= WS_END, "d_ws map");

constexpr int LDS_BYTES = 147456;
constexpr int NSTEPS = 13;

struct Args { const float* in[19]; float* out; unsigned char* ws; int ph_lo, ph_hi; };

struct Ctx {
    LAS unsigned char* lds;
    int tid, lane, wave, vcu, G;
    float* out; unsigned char* ws;
};
constexpr int PARAM_OFF = 131072;
__device__ __forceinline__ const float* inp(const Ctx& F, int k) {
    volatile LAS unsigned* p = (volatile LAS unsigned*)(F.lds + PARAM_OFF) + 2 * k;
    const unsigned lo = __builtin_amdgcn_readfirstlane(p[0]), hi = __builtin_amdgcn_readfirstlane(p[1]);
    return (const float*)(((unsigned long long)hi << 32) | (unsigned long long)lo);
}

__device__ __forceinline__ void transpose_item(const float* __restrict__ W, int ldw, int c0, int ncols, bf16* __restrict__ WT, int ldt, int row_off, float scale, LAS float* scr, int item, int lane) {
    const int nblk = ncols / 32, kb = item / nblk, nb = item % nblk, k0 = 64 * kb, n0 = 32 * nb;
#pragma unroll
    for (int i = 0; i < 32; ++i) { const int kk = 2 * i + (lane >> 5); scr[kk * 33 + (lane & 31)] = W[(size_t)(k0 + kk) * ldw + c0 + n0 + (lane & 31)] * scale; }
    asm volatile("s_waitcnt lgkmcnt(0)" ::: "memory");
    const int c = lane & 7;
#pragma unroll
    for (int j = 0; j < 4; ++j) { const int n = (lane >> 3) + 8 * j; const LAS float* s = scr + (8 * c) * 33 + n;
        v4u o; o.x = pk2(s[0 * 33], s[1 * 33]); o.y = pk2(s[2 * 33], s[3 * 33]); o.z = pk2(s[4 * 33], s[5 * 33]); o.w = pk2(s[6 * 33], s[7 * 33]);
        *(v4u*)(WT + (size_t)(row_off + n0 + n) * ldt + k0 + 8 * c) = o; }
    asm volatile("s_waitcnt lgkmcnt(0)" ::: "memory");
}

__device__ __forceinline__ void rms_row_to_bf16(const float* __restrict__ xrow, const float* __restrict__ g, bf16* __restrict__ orow, int lane, f32x4 (&v)[4]) {
    const f32x4* xr = (const f32x4*)xrow + lane; const f32x4* gr = (const f32x4*)g + lane;
    float s2 = 0.f;
#pragma unroll
    for (int j = 0; j < 4; ++j) { v[j] = xr[64 * j]; s2 += (v[j].x * v[j].x + v[j].y * v[j].y) + (v[j].z * v[j].z + v[j].w * v[j].w); }
    const float rstd = 1.0f / sqrtf(wave_sum(s2) * (1.f / DM) + EPS);
    unsigned long long* o8 = (unsigned long long*)orow + lane;
#pragma unroll
    for (int j = 0; j < 4; ++j) { const f32x4 gg = gr[64 * j]; v[j] = v[j] * rstd * gg;
        o8[64 * j] = (unsigned long long)pk2(v[j].x, v[j].y) | ((unsigned long long)pk2(v[j].z, v[j].w) << 32); }
}

__device__ __forceinline__ float log_sigmoid(float x) { return fminf(x, 0.f) - log1pf(expf(-fabsf(x))); }

__device__ __forceinline__ void step_prologue(const Ctx& F) {
    LAS float* scr = (LAS float*)(F.lds + F.wave * 16384);
    const int gw = F.vcu * NWAVES + F.wave, NGW = F.G * NWAVES;
    unsigned char* ws = F.ws;
    const float* w_in = inp(F, 3);
    const float QS = 0.125f * LOG2E;
    constexpr int I_IN = 16 * 16, I_OUT = 16 * 32, I_MKV = 16 * 64, I_MO = 16 * 32, I_UP = 16 * 44, I_DN = 44 * 32;
    constexpr int NITEMS = 6 * I_IN + I_OUT + I_MKV + I_MO + 4 * I_UP + I_DN;
    for (int it = gw; it < NITEMS; it += NGW) {
        int r = it;
        if (r < 6 * I_IN) { const int blk = r / I_IN; r -= blk * I_IN;
            bf16* dst = (blk == 2 || blk == 5) ? (bf16*)(ws + WS_WV) : (bf16*)(ws + WS_WQK);
            const int row_off = (blk == 0) ? 0 : (blk == 1) ? 512 : (blk == 2) ? 0 : (blk == 3) ? 1024 : (blk == 4) ? 1536 : 512;
            const float sc = (blk == 0 || blk == 3) ? QS : 1.f;
            transpose_item(w_in, INC, blk * 512, 512, dst, DM, row_off, sc, scr, r, F.lane); continue; }
        r -= 6 * I_IN;
        if (r < I_OUT) { transpose_item(inp(F, 7), DM, 0, DM, (bf16*)(ws + WS_WOUT), DM, 0, 1.f, scr, r, F.lane); continue; } r -= I_OUT;
        if (r < I_MKV) { transpose_item(inp(F, 11), 2 * DM, 0, 2 * DM, (bf16*)(ws + WS_WMKV), DM, 0, 1.f, scr, r, F.lane); continue; } r -= I_MKV;
        if (r < I_MO) { transpose_item(inp(F, 12), DM, 0, DM, (bf16*)(ws + WS_WMO), DM, 0, 1.f, scr, r, F.lane); continue; } r -= I_MO;
        if (r < 4 * I_UP) { const int blk = r / I_UP; r -= blk * I_UP;
            const int c0 = (blk == 0) ? 0 : (blk == 1) ? DFF : (blk == 2) ? HFF : DFF + HFF;
            transpose_item(inp(F, 14), 2 * DFF, c0, HFF, (bf16*)(ws + WS_WUP), DM, blk * HFF, 1.f, scr, r, F.lane); continue; }
        r -= 4 * I_UP;
        transpose_item(inp(F, 17), DM, 0, DM, (bf16*)(ws + WS_WDOWN), DFF, 0, 1.f, scr, r, F.lane);
    }
    { const float* wq = inp(F, 10); bf16* dq = (bf16*)(ws + WS_WMQN); const float sc = 0.0625f * LOG2E;
      for (int i = (F.vcu * 512 + F.tid); i < DM * DM / 4; i += F.G * 512) { const f32x4 v = ((const f32x4*)wq)[i]; v2u o; o.x = pk2(v.x * sc, v.y * sc); o.y = pk2(v.z * sc, v.w * sc); ((v2u*)dq)[i] = o; } }
    { const float* x = inp(F, 0); const float* g = inp(F, 2); const float* bfg = inp(F, 4); bf16* H = (bf16*)(ws + WS_H); float* LF = (float*)(ws + WS_LF);
      LAS float* wf = (LAS float*)F.lds;
      __syncthreads();
#pragma unroll
      for (int kk = 0; kk < 2; ++kk) { const int k = F.tid + 512 * kk; const f32x4 wa = *(const f32x4*)(w_in + (size_t)k * INC + 3072), wb = *(const f32x4*)(w_in + (size_t)k * INC + 3076);
          wf[k] = wa.x; wf[1024 + k] = wa.y; wf[2048 + k] = wa.z; wf[3072 + k] = wa.w; wf[4096 + k] = wb.x; wf[5120 + k] = wb.y; wf[6144 + k] = wb.z; wf[7168 + k] = wb.w; }
      __syncthreads();
      for (int m = gw; m < M; m += NGW) {
          f32x4 v[4]; rms_row_to_bf16(x + (size_t)m * DM, g, H + (size_t)m * DM, F.lane, v);
          float acc[8];
#pragma unroll
          for (int j8 = 0; j8 < 8; ++j8) { float a = 0.f;
#pragma unroll
              for (int j = 0; j < 4; ++j) { const f32x4 wv = *(LAS f32x4*)(wf + j8 * 1024 + 4 * F.lane + 256 * j); a += (v[j].x * wv.x + v[j].y * wv.y) + (v[j].z * wv.z + v[j].w * wv.w); }
              acc[j8] = wave_sum(a); }
          if (F.lane < 8) { float a = acc[0];
#pragma unroll
              for (int j = 1; j < 8; ++j) a = (F.lane == j) ? acc[j] : a;
              const int bb = m / SEQ, s = m % SEQ; LF[(size_t)(bb * 8 + F.lane) * SEQ + s] = log_sigmoid(a + bfg[F.lane]); }
      } }
    { const float* mem = inp(F, 1); const float* g = inp(F, 9); bf16* MN = (bf16*)(ws + WS_MN);
      for (int m = gw; m < BATCH * NMEM; m += NGW) { f32x4 v[4]; rms_row_to_bf16(mem + (size_t)m * DM, g, MN + (size_t)m * DM, F.lane, v); } }
}

__device__ __forceinline__ void step_scan(const Ctx& F) {
    if (blockIdx.x >= 16) return;
    const int seq = blockIdx.x;
    const size_t off = (size_t)seq * SEQ + F.wave * 1024 + F.lane * 16;
    const float* src = (const float*)(F.ws + WS_LF) + off; float* dst = (float*)(F.ws + WS_C2) + off;
    float v[16];
#pragma unroll
    for (int i = 0; i < 4; ++i) { const f32x4 t = ((const f32x4*)src)[i]; v[4 * i] = t.x; v[4 * i + 1] = t.y; v[4 * i + 2] = t.z; v[4 * i + 3] = t.w; }
#pragma unroll
    for (int i = 1; i < 16; ++i) v[i] += v[i - 1];
    const float tot = v[15]; float inc = tot;
#pragma unroll
    for (int o = 1; o < 64; o <<= 1) { const float u = __shfl_up(inc, o); if (F.lane >= o) inc += u; }
    LAS float* wt = (LAS float*)(F.lds + 65536);
    if (F.lane == 63) wt[F.wave] = inc;
    __syncthreads();
    float pre = inc - tot;
    for (int w2 = 0; w2 < F.wave; ++w2) pre += wt[w2];
#pragma unroll
    for (int i = 0; i < 4; ++i) { f32x4 o; o.x = (pre + v[4 * i]) * LOG2E; o.y = (pre + v[4 * i + 1]) * LOG2E; o.z = (pre + v[4 * i + 2]) * LOG2E; o.w = (pre + v[4 * i + 3]) * LOG2E; ((f32x4*)dst)[i] = o; }
}

__device__ __forceinline__ void step_mixnorm(const Ctx& F) {
    const int gw = F.vcu * NWAVES + F.wave, NGW = F.G * NWAVES; bf16* AO = (bf16*)(F.ws + WS_AO);
    const float* gf = inp(F, 5); const float* gs = inp(F, 6);
    for (int m = gw; m < M; m += NGW) {
        v4u* row = (v4u*)(AO + (size_t)m * DM) + F.lane;
#pragma unroll
        for (int hf = 0; hf < 2; ++hf) {
            const v4u w = row[64 * hf]; float v[8];
            v[0] = bflo(w.x); v[1] = bfhi(w.x); v[2] = bflo(w.y); v[3] = bfhi(w.y); v[4] = bflo(w.z); v[5] = bfhi(w.z); v[6] = bflo(w.w); v[7] = bfhi(w.w);
            float s2 = 0.f;
#pragma unroll
            for (int e = 0; e < 8; ++e) s2 += v[e] * v[e];
            const float rstd = 1.0f / sqrtf(wave_sum(s2) * (1.f / 512.f) + EPS);
            const float* g = (hf ? gs : gf) + 8 * F.lane; const f32x4 ga = *(const f32x4*)g, gb = *(const f32x4*)(g + 4);
            v4u o; o.x = pk2(v[0] * rstd * ga.x, v[1] * rstd * ga.y); o.y = pk2(v[2] * rstd * ga.z, v[3] * rstd * ga.w); o.z = pk2(v[4] * rstd * gb.x, v[5] * rstd * gb.y); o.w = pk2(v[6] * rstd * gb.z, v[7] * rstd * gb.w);
            row[64 * hf] = o;
        }
    }
}


__device__ __forceinline__ void step_final(const Ctx& F) {
    const int gw = F.vcu * NWAVES + F.wave, NGW = F.G * NWAVES; const float* g = inp(F, 18);
    for (int m = gw; m < M; m += NGW) {
        f32x4* xr = (f32x4*)(F.out + (size_t)m * DM) + F.lane; const f32x4* gr = (const f32x4*)g + F.lane; f32x4 v[4]; float s2 = 0.f;
#pragma unroll
        for (int j = 0; j < 4; ++j) { v[j] = xr[64 * j]; s2 += (v[j].x * v[j].x + v[j].y * v[j].y) + (v[j].z * v[j].z + v[j].w * v[j].w); }
        const float rstd = 1.0f / sqrtf(wave_sum(s2) * (1.f / DM) + EPS);
#pragma unroll
        for (int j = 0; j < 4; ++j) xr[64 * j] = v[j] * rstd * gr[64 * j];
    }
}


__device__ __forceinline__ void unpack8(const v4u a, float (&o)[8]) { o[0] = bflo(a.x); o[1] = bfhi(a.x); o[2] = bflo(a.y); o[3] = bfhi(a.y); o[4] = bflo(a.z); o[5] = bfhi(a.z); o[6] = bflo(a.w); o[7] = bfhi(a.w); }
__device__ __forceinline__ void step_conv(const Ctx& F, int half) {
    const bf16* U = (const bf16*)(F.ws + WS_U); bf16* ACT = (bf16*)(F.ws + WS_ACT); const float* cw = inp(F, 15); const float* cb = inp(F, 16);
    constexpr int NCC = HFF / 8  , NRC = M / 8, NIT = NCC * NRC;
    for (int item = F.vcu * 512 + F.tid; item < NIT; item += F.G * 512) {
        const int cc = item % NCC, rc = item / NCC, t0 = rc * 8, j0 = cc * 8, fg = half * HFF + j0, fv = DFF + fg;
        const bool first = (t0 % SEQ) == 0;
        v4u ug[10], uv[10];
#pragma unroll
        for (int rr = 0; rr < 10; ++rr) {
            if (rr < 2 && first) { ug[rr] = (v4u){0u, 0u, 0u, 0u}; uv[rr] = (v4u){0u, 0u, 0u, 0u}; }
            else { const size_t t = (size_t)(t0 - 2 + rr); ug[rr] = *(const v4u*)(U + t * DFF + j0); uv[rr] = *(const v4u*)(U + t * DFF + HFF + j0); }
        }
        float wg[3][8], wv[3][8], bg[8], bv[8];
#pragma unroll
        for (int i = 0; i < 3; ++i)
#pragma unroll
            for (int e = 0; e < 8; e += 4) { const f32x4 a = *(const f32x4*)(cw + (size_t)i * 2 * DFF + fg + e), c = *(const f32x4*)(cw + (size_t)i * 2 * DFF + fv + e);
                wg[i][e] = a.x; wg[i][e + 1] = a.y; wg[i][e + 2] = a.z; wg[i][e + 3] = a.w; wv[i][e] = c.x; wv[i][e + 1] = c.y; wv[i][e + 2] = c.z; wv[i][e + 3] = c.w; }
#pragma unroll
        for (int e = 0; e < 8; e += 4) { const f32x4 a = *(const f32x4*)(cb + fg + e), c = *(const f32x4*)(cb + fv + e);
            bg[e] = a.x; bg[e + 1] = a.y; bg[e + 2] = a.z; bg[e + 3] = a.w; bv[e] = c.x; bv[e + 1] = c.y; bv[e + 2] = c.z; bv[e + 3] = c.w; }
        float g2[8], g1[8], v2[8], v1[8];
        unpack8(ug[0], g2); unpack8(ug[1], g1); unpack8(uv[0], v2); unpack8(uv[1], v1);
#pragma unroll
        for (int rr = 0; rr < 8; ++rr) {
            float g0[8], v0[8], o[8];
            unpack8(ug[rr + 2], g0); unpack8(uv[rr + 2], v0);
#pragma unroll
            for (int e = 0; e < 8; ++e) {
                const float gt = bg[e] + wg[0][e] * g2[e] + wg[1][e] * g1[e] + wg[2][e] * g0[e];
                const float vl = bv[e] + wv[0][e] * v2[e] + wv[1][e] * v1[e] + wv[2][e] * v0[e];
                o[e] = gt / (1.f + __expf(-gt)) * vl;
                g2[e] = g1[e]; g1[e] = g0[e]; v2[e] = v1[e]; v1[e] = v0[e];
            }
            v4u ov; ov.x = pk2(o[0], o[1]); ov.y = pk2(o[2], o[3]); ov.z = pk2(o[4], o[5]); ov.w = pk2(o[6], o[7]);
            *(v4u*)(ACT + (size_t)(t0 + rr) * DFF + fg) = ov;
        }
    }
}

__device__ __forceinline__ void step_attention(const Ctx& F) {
    const bf16* QK = (const bf16*)(F.ws + WS_QK); const bf16* VT = (const bf16*)(F.ws + WS_VT); const float* C2 = (const float*)(F.ws + WS_C2); bf16* AO = (bf16*)(F.ws + WS_AO);
#pragma nounroll
    for (int id = F.vcu; id < 512; id += F.G) { const int v = id & 255, bh = v >> 4, s = v & 15, qb = (id >> 8) ? 31 - s : s; att::unit<0>(bh >> 3, bh & 7, qb, QK, VT, C2, AO, F.lds); }
#pragma nounroll
    for (int id = F.vcu; id < 512; id += F.G) { const int v = id & 255, bh = v >> 4, s = v & 15, qb = (id >> 8) ? 31 - s : s; att::unit<1>(bh >> 3, bh & 7, qb, QK, VT, C2, AO, F.lds); }
}

struct Job { pg8::Gemm g; int G, c; bf16* O; int ldc; const float* base; float* out; bf16* hn; const float* gn; float* ps_out; const float* ps_in; };

__device__ __forceinline__ bool bf16_job(const Ctx& F, int step, int j, Job& J) {
    unsigned char* ws = F.ws; const int bx = (int)blockIdx.x;
    J.G = F.G; J.c = bx; J.ps_in = nullptr;
    if (step == 1) {
        if (j == 0) { J.g = pg8::Gemm{(const bf16*)(ws + WS_MN), (const bf16*)(ws + WS_WMKV), BATCH * NMEM, 2 * DM, DM, DM, DM}; J.O = (bf16*)(ws + WS_KVM); J.ldc = 2 * DM; return true; }
        if (j == 1) { J.g = pg8::Gemm{(const bf16*)(ws + WS_H), (const bf16*)(ws + WS_WQK), M, 2048, DM, DM, DM}; J.O = (bf16*)(ws + WS_QK); J.ldc = 2048; return true; }
        if (j == 2) { J.g = pg8::Gemm{(const bf16*)(ws + WS_WV), (const bf16*)(ws + WS_H), DM, M, DM, DM, DM}; J.O = (bf16*)(ws + WS_VT); J.ldc = M; return true; }
        return false;
    }
    if (step == 3) {
        if (j != 0 || bx >= 64) return false;
        const int ci = bx >> 2, kind = ci >> 3, bb = (ci >> 2) & 1, hh = ci & 3; J.G = 4; J.c = bx & 3;
        const bf16* KVM = (const bf16*)(ws + WS_KVM);
        if (kind == 0) {
            J.g = pg8::Gemm{KVM + (size_t)(bb * NMEM) * 2048 + hh * 256, (const bf16*)(ws + WS_WMQN) + hh * 256, 256, DM, 256, 2048, DM};
            J.O = (bf16*)(ws + WS_WK) + (size_t)(bb * DM + hh * 256) * DM; J.ldc = DM;
        } else {
            J.g = pg8::Gemm{(const bf16*)(ws + WS_WMO) + hh * 256, KVM + (size_t)(bb * NMEM) * 2048 + DM + hh * 256, DM, 256, 256, DM, 2048};
            J.O = (bf16*)(ws + WS_VW) + (size_t)bb * DM * DM + hh * 256; J.ldc = DM;
        }
        return true;
    }
    if (step == 7 || step == 9) {
        if (j != 0) return false;
        const int half = (step == 9);
        J.g = pg8::Gemm{(const bf16*)(ws + WS_H), (const bf16*)(ws + WS_WUP) + (size_t)half * DFF * DM, M, DFF, DM, DM, DM}; J.O = (bf16*)(ws + WS_U); J.ldc = DFF; J.ps_in = (const float*)(ws + WS_PS); return true;
    }
    return false;
}
__device__ __forceinline__ bool f32_job(const Ctx& F, int step, Job& J) {
    unsigned char* ws = F.ws; const int bx = (int)blockIdx.x;
    J.G = F.G; J.c = bx; J.hn = nullptr; J.gn = nullptr; J.ps_out = nullptr;
    if (step == 4) { J.g = pg8::Gemm{(const bf16*)(ws + WS_AO), (const bf16*)(ws + WS_WOUT), M, DM, DM, DM, DM}; J.base = inp(F, 0); J.out = F.out; J.ldc = DM;
        J.hn = (bf16*)(ws + WS_H); J.gn = inp(F, 8); J.ps_out = (float*)(ws + WS_PS); return true; }
    if (step == 6) {
        const int bb = bx & 1; J.G = F.G >> 1; J.c = bx >> 1;
        if ((F.G & 1) && bx == F.G - 1) return false;
        J.g = pg8::Gemm{(const bf16*)(ws + WS_P) + (size_t)bb * SEQ * DM, (const bf16*)(ws + WS_VW) + (size_t)bb * DM * DM, SEQ, DM, DM, DM, DM}; J.out = F.out + (size_t)bb * SEQ * DM; J.base = J.out; J.ldc = DM;
        J.hn = (bf16*)(ws + WS_H) + (size_t)bb * SEQ * DM; J.gn = inp(F, 13); J.ps_out = (float*)(ws + WS_PS) + (size_t)bb * SEQ * 16; return true;
    }
    if (step == 11) { J.g = pg8::Gemm{(const bf16*)(ws + WS_ACT), (const bf16*)(ws + WS_WDOWN), M, DM, DFF, DFF, DFF}; J.base = F.out; J.out = F.out; J.ldc = DM; return true; }
    return false;
}

__global__ void __launch_bounds__(NWAVES * 64, 2) fwd_kernel(Args args) {
    extern __shared__ __attribute__((aligned(16))) unsigned char lds[];
    cg::grid_group grid = cg::this_grid();
    Ctx F0;
    F0.lds = (LAS unsigned char*)lds; F0.tid = threadIdx.x; F0.lane = F0.tid & 63; F0.wave = __builtin_amdgcn_readfirstlane(F0.tid >> 6);
    F0.G = gridDim.x; { const int bx = blockIdx.x; F0.vcu = (F0.G % 8 == 0) ? (bx % 8) * (F0.G / 8) + bx / 8 : bx; }
    F0.out = args.out; F0.ws = args.ws;
    if (F0.tid == 0) { LAS unsigned long long* pl = (LAS unsigned long long*)(F0.lds + PARAM_OFF);
#pragma unroll
        for (int i = 0; i < 19; ++i) pl[i] = (unsigned long long)args.in[i]; }
    __syncthreads();
    const int lo = args.ph_lo, hi = args.ph_hi;
#pragma nounroll
    for (int si = lo; si < hi; ++si) {
#if defined(PROBE_REP)
        const int step = si <= PROBE_REP ? si : si - 1;
#else
        const int step = si;
#endif
        Ctx F = F0;
        asm volatile("" : "+v"(F.tid)); F.lane = F.tid & 63; F.wave = __builtin_amdgcn_readfirstlane(F.tid >> 6);
        asm volatile("" : "+s"(F.vcu), "+s"(F.G), "+s"(F.ws), "+s"(F.out));
        switch (step) {
            case 0: step_prologue(F); break;
            case 1: step_scan(F); break;
            case 2: step_attention(F); break;
            case 3: step_mixnorm(F); break;
            case 8: step_conv(F, 0); break;
            case 10: step_conv(F, 1); break;
            case 12: step_final(F); break;
            default: break;
        }
        __syncthreads();
#pragma nounroll
        for (int j = 0; j < 3; ++j) {
            Job J;
            if (!bf16_job(F, step, j, J)) break;
            pg8::StaticOrder S; S.init(J.g.M, J.g.N, J.G, J.c);
            pg8::EpiBf16 E{J.O, J.ldc, J.ps_in};
            pg8::gemm_phase<pg8::EpiBf16, pg8::StaticOrder, PG8_ALIGN, PG8_SP2>(F.lds, J.g, S, E);
            __syncthreads();
        }
        {
            Job J;
            if (f32_job(F, step, J)) {
                pg8::StaticOrder S; S.init(J.g.M, J.g.N, J.G, J.c);
                pg8::EpiResF32 E{J.base, J.out, J.ldc, J.hn, J.gn, J.ps_out};
                pg8::gemm_phase<pg8::EpiResF32, pg8::StaticOrder, PG8_ALIGN, PG8_SP2>(F.lds, J.g, S, E);
                __syncthreads();
            }
        }
        if (step == 5 && (int)blockIdx.x < 2 * (F.G >> 1)) {
            const int bx = (int)blockIdx.x, bb = bx & 1;
            pg8::Gemm g{(const bf16*)(F.ws + WS_H) + (size_t)bb * SEQ * DM, (const bf16*)(F.ws + WS_WK) + (size_t)bb * DM * DM, SEQ, DM, DM, DM, DM};
            pg8::StaticOrder S; S.init(SEQ, DM, F.G >> 1, bx >> 1);
            pg8::EpiSoftmax E{(const float*)(F.ws + WS_PS) + (size_t)bb * SEQ * 16, (bf16*)(F.ws + WS_P) + (size_t)bb * SEQ * DM, DM};
            pg8::gemm_phase<pg8::EpiSoftmax, pg8::StaticOrder, false, PG8_SP2>(F.lds, g, S, E);
            __syncthreads();
        }
        if (si + 1 < hi) grid.sync();
    }
}

#ifndef MK_PER_STEP
#define MK_PER_STEP 0
#endif
extern "C" void kernel_launch(void* const* d_in, const int* in_sizes, int n_in, void* d_out, int out_size, void* d_ws, size_t ws_size, hipStream_t stream) {
    static int grid = 0;
    if (grid == 0) {
        if (n_in != 19 || in_sizes[0] != M * DM || out_size != M * DM || ws_size < WS_END) { fprintf(stderr, "kernel_launch: unexpected shapes (n_in %d, in0 %d, out %d, ws %zu)\n", n_in, n_in > 0 ? in_sizes[0] : -1, out_size, ws_size); grid = -1; return; }
        int dev = 0, cus = 0, per_cu = 0;
        if (hipGetDevice(&dev) != hipSuccess || hipDeviceGetAttribute(&cus, hipDeviceAttributeMultiprocessorCount, dev) != hipSuccess) { grid = -1; return; }
        if (hipFuncSetAttribute((const void*)fwd_kernel, hipFuncAttributeMaxDynamicSharedMemorySize, LDS_BYTES) != hipSuccess) { fprintf(stderr, "kernel_launch: hipFuncSetAttribute failed\n"); grid = -1; return; }
        if (hipOccupancyMaxActiveBlocksPerMultiprocessor(&per_cu, (const void*)fwd_kernel, NWAVES * 64, LDS_BYTES) != hipSuccess || per_cu < 1) { fprintf(stderr, "kernel_launch: occupancy query says %d\n", per_cu); per_cu = 1; }
        (void)hipGetLastError();
        grid = cus;
    }
    if (grid < 0) return;
    Args a{};
    for (int i = 0; i < 19; ++i) a.in[i] = (const float*)d_in[i];
    a.out = (float*)d_out; a.ws = (unsigned char*)d_ws;
#if MK_PER_STEP
    for (int s = 0; s < NSTEPS; ++s) { a.ph_lo = s; a.ph_hi = s + 1; hipLaunchKernelGGL(fwd_kernel, dim3(grid), dim3(NWAVES * 64), LDS_BYTES, stream, a); }
#else
#if defined(PROBE_REP)
    a.ph_lo = 0; a.ph_hi = NSTEPS + 1;
#else
    a.ph_lo = 0; a.ph_hi = NSTEPS;
#endif
    void* kargs[] = {&a};
    const hipError_t e = hipLaunchCooperativeKernel((const void*)fwd_kernel, dim3(grid), dim3(NWAVES * 64), kargs, LDS_BYTES, stream);
    if (e != hipSuccess) fprintf(stderr, "kernel_launch: cooperative launch failed: %s (grid %d)\n", hipGetErrorString(e), grid);
#endif
}
```

```cpp
#include <hip/hip_runtime.h>
#include <hip/hip_cooperative_groups.h>
#include <cstdio>
#include <cstdint>
namespace cg = cooperative_groups;
namespace pg8 {
#define PG8_LAS __attribute__((address_space(3)))
typedef unsigned short bf16_t;
typedef short bf16x8 __attribute__((ext_vector_type(8)));
typedef float f32x4 __attribute__((ext_vector_type(4)));
typedef unsigned u32x4 __attribute__((ext_vector_type(4)));
constexpr int BM = 256, BK = 64, HALF = 128, HTB = HALF * BK * 2  , STAGE_BYTES = 8 * HTB, NXCD = 8, WGM = 8;

__host__ __device__ __forceinline__ int lds_byte(int r, int c) { const int st = (r >> 4) * 2 + (c >> 5), rr = r & 15, cc = c & 31, ob = rr * 64 + cc * 2; return st * 1024 + (ob ^ (((ob >> 9) & 1) << 5)); }
__host__ __device__ __forceinline__ void stage_rc(int b, int& R, int& C) { const int st = b / 1024, sb = b % 1024, swz = sb ^ (((sb >> 9) & 1) << 5); R = (st >> 1) * 16 + swz / 64; C = (st & 1) * 32 + (swz % 64) / 2; }
__host__ __device__ __forceinline__ int perm32(int rho) { const int n = rho >> 4, i = rho & 15; return 8 * (i >> 2) + 4 * n + (i & 3); }

struct Unit { int pm, pn; };
struct Gemm { const bf16_t* A; const bf16_t* Bt; int M, N, K, lda, ldb; };

struct StaticOrder {
    int nM, nN, nwg, G, c;
    __host__ __device__ void init(int M, int N, int G_, int c_) { nM = M / BM; nN = N / BM; nwg = nM * nN; G = G_; c = c_; }
    __host__ __device__ bool next(int i, Unit& u) const {
        const long L = (long)i * G + c; if (L >= nwg) return false;
        int wgid = (int)L; { const int q = nwg / NXCD, r = nwg % NXCD, xcd = wgid % NXCD, off = wgid / NXCD; wgid = (xcd < r ? xcd * (q + 1) : r * (q + 1) + (xcd - r) * q) + off; }
        const int nig = WGM * nN, gid = wgid / nig, fm = gid * WGM, gsz = (nM - fm) < WGM ? (nM - fm) : WGM;
        u.pm = fm + ((wgid % nig) % gsz); u.pn = (wgid % nig) / gsz; return true;
    }
    __device__ __forceinline__ void a_ready(const Unit&) const {}
    __device__ __forceinline__ void done(const Unit&) const {}
};

__device__ __forceinline__ unsigned cvt_pk_bf16(float lo, float hi) { unsigned r; asm volatile("v_cvt_pk_bf16_f32 %0, %1, %2" : "=v"(r) : "v"(lo), "v"(hi)); return r; }
typedef float f32x2 __attribute__((ext_vector_type(2)));
__device__ __forceinline__ f32x2 gelu_pk(f32x2 v) {
    const f32x2 av = __builtin_elementwise_abs(v), d = av * 0.2316418882f + 1.0f;
    f32x2 t; t.x = __builtin_amdgcn_rcpf(d.x); t.y = __builtin_amdgcn_rcpf(d.y);
    f32x2 q = t * 0.5307027145f + (-0.7265760135f); q = q * t + 0.7107068705f; q = q * t + (-0.142248368f); q = q * t + 0.127414796f; q = q * t;
    const f32x2 s = (v * v) * (-0.72134752044f);
    f32x2 e; e.x = __builtin_amdgcn_exp2f(s.x); e.y = __builtin_amdgcn_exp2f(s.y);
    const f32x2 m = v * (q * e), r = v - m;
    f32x2 o; o.x = v.x < 0.f ? m.x : r.x; o.y = v.y < 0.f ? m.y : r.y; return o;
}

__device__ __forceinline__ float row_rstd(const float* ps, size_t r) {
    const f32x4 a = *(const f32x4*)(ps + r * 16), b = *(const f32x4*)(ps + r * 16 + 4), c = *(const f32x4*)(ps + r * 16 + 8), d = *(const f32x4*)(ps + r * 16 + 12);
    const float s = (((a[0] + a[1]) + (a[2] + a[3])) + ((b[0] + b[1]) + (b[2] + b[3]))) + (((c[0] + c[1]) + (c[2] + c[3])) + ((d[0] + d[1]) + (d[2] + d[3])));
    return 1.0f / sqrtf(s * (1.0f / 1024.0f) + 1e-6f);
}
struct EpiBf16 {
    static constexpr bool PERM = true, AFTER_DRAIN = false;
    bf16_t* O; int ldc; const float* ps;
    __device__ __forceinline__ void operator()(const f32x4 (&acc)[2][2][4][2], const Unit& u, int wr, int wc, int fr, int fq) const {
        const int row0 = u.pm * BM + wr * 64 + fr, col0 = u.pn * BM + wc * 32 + 8 * fq;
#pragma unroll
        for (int ai = 0; ai < 2; ++ai)
#pragma unroll
            for (int m = 0; m < 4; ++m) { const size_t r = (size_t)(row0 + ai * HALF + m * 16); bf16_t* rowp = O + r * ldc + col0;
                const float rs = ps ? row_rstd(ps, r) : 1.0f;
#pragma unroll
                for (int bj = 0; bj < 2; ++bj) { const f32x4 v0 = acc[ai][bj][m][0] * rs, v1 = acc[ai][bj][m][1] * rs;
                    u32x4 w; w.x = cvt_pk_bf16(v0[0], v0[1]); w.y = cvt_pk_bf16(v0[2], v0[3]); w.z = cvt_pk_bf16(v1[0], v1[1]); w.w = cvt_pk_bf16(v1[2], v1[3]);
                    *(u32x4*)(rowp + bj * HALF) = w; } }
    }
};
struct EpiResF32 {
    static constexpr bool PERM = false, AFTER_DRAIN = false;
    const float* base; float* out; int ldc; bf16_t* hn; const float* gn; float* ps_out;
    __device__ __forceinline__ void operator()(const f32x4 (&acc)[2][2][4][2], const Unit& u, int wr, int wc, int fr, int fq) const {
        const int col0 = u.pn * BM + wc * 32 + 4 * fq;
        f32x4 gv[2][2];
#pragma unroll
        for (int bj = 0; bj < 2; ++bj)
#pragma unroll
            for (int n = 0; n < 2; ++n) gv[bj][n] = hn ? *(const f32x4*)(gn + col0 + bj * HALF + n * 16) : (f32x4){0.f, 0.f, 0.f, 0.f};
#pragma unroll
        for (int ai = 0; ai < 2; ++ai)
#pragma unroll
            for (int m = 0; m < 4; ++m) { const size_t r = (size_t)(u.pm * BM + ai * HALF + wr * 64 + m * 16 + fr), off = r * ldc + col0; float ss = 0.f;
#pragma unroll
                for (int bj = 0; bj < 2; ++bj)
#pragma unroll
                    for (int n = 0; n < 2; ++n) { f32x4 v = acc[ai][bj][m][n]; if (base) v += *(const f32x4*)(base + off + bj * HALF + n * 16); *(f32x4*)(out + off + bj * HALF + n * 16) = v;
                        if (hn) { ss += (v[0] * v[0] + v[1] * v[1]) + (v[2] * v[2] + v[3] * v[3]); const f32x4 w = v * gv[bj][n];
                            typedef unsigned u32x2 __attribute__((ext_vector_type(2))); u32x2 p; p.x = cvt_pk_bf16(w[0], w[1]); p.y = cvt_pk_bf16(w[2], w[3]); *(u32x2*)(hn + off + bj * HALF + n * 16) = p; } }
                if (hn) { ss += __shfl_xor(ss, 16); ss += __shfl_xor(ss, 32); if (fq == 0) ps_out[r * 16 + u.pn * 4 + wc] = ss; } }
    }
};
struct EpiSoftmax {
    static constexpr bool PERM = false, AFTER_DRAIN = true;
    const float* ps; bf16_t* P; int ldc;
    __device__ __forceinline__ void fused(f32x4 (&acc)[2][2][4][2], const Unit& u, int wr, int wc, int fr, int fq, PG8_LAS unsigned char* lds, int wid, int lane) const {
        PG8_LAS float* T = (PG8_LAS float*)lds;
        PG8_LAS float* T2 = T + 1024;
        const int col0 = u.pn * BM + wc * 32 + 4 * fq;
#pragma unroll
        for (int ai = 0; ai < 2; ++ai)
#pragma unroll
            for (int m = 0; m < 4; ++m) { const int rl = ai * HALF + wr * 64 + m * 16 + fr; const float rs = row_rstd(ps, (size_t)(u.pm * BM + rl)); float mx = -3.0e38f;
#pragma unroll
                for (int bj = 0; bj < 2; ++bj)
#pragma unroll
                    for (int n = 0; n < 2; ++n) { f32x4 v = acc[ai][bj][m][n] * rs; acc[ai][bj][m][n] = v; mx = fmaxf(fmaxf(mx, fmaxf(v[0], v[1])), fmaxf(v[2], v[3])); }
                mx = fmaxf(mx, __shfl_xor(mx, 16)); mx = fmaxf(mx, __shfl_xor(mx, 32));
                if (fq == 0) T[rl * 4 + wc] = mx; }
        asm volatile("s_waitcnt lgkmcnt(0)" ::: "memory"); __builtin_amdgcn_s_barrier(); asm volatile("" ::: "memory");
#pragma unroll
        for (int ai = 0; ai < 2; ++ai)
#pragma unroll
            for (int m = 0; m < 4; ++m) { const int rl = ai * HALF + wr * 64 + m * 16 + fr; const f32x4 t = *(const PG8_LAS f32x4*)(T + rl * 4); const float mx = fmaxf(fmaxf(t[0], t[1]), fmaxf(t[2], t[3])); float s = 0.f;
#pragma unroll
                for (int bj = 0; bj < 2; ++bj)
#pragma unroll
                    for (int n = 0; n < 2; ++n) { f32x4 v = acc[ai][bj][m][n]; v[0] = __builtin_amdgcn_exp2f(v[0] - mx); v[1] = __builtin_amdgcn_exp2f(v[1] - mx); v[2] = __builtin_amdgcn_exp2f(v[2] - mx); v[3] = __builtin_amdgcn_exp2f(v[3] - mx);
                        acc[ai][bj][m][n] = v; s += (v[0] + v[1]) + (v[2] + v[3]); }
                s += __shfl_xor(s, 16); s += __shfl_xor(s, 32);
                if (fq == 0) T2[rl * 4 + wc] = s; }
        asm volatile("s_waitcnt lgkmcnt(0)" ::: "memory"); __builtin_amdgcn_s_barrier(); asm volatile("" ::: "memory");
#pragma unroll
        for (int ai = 0; ai < 2; ++ai)
#pragma unroll
            for (int m = 0; m < 4; ++m) { const int rl = ai * HALF + wr * 64 + m * 16 + fr; const f32x4 t = *(const PG8_LAS f32x4*)(T2 + rl * 4); const float inv = 1.0f / ((t[0] + t[1]) + (t[2] + t[3]));
                bf16_t* rowp = P + (size_t)(u.pm * BM + rl) * ldc + col0;
#pragma unroll
                for (int bj = 0; bj < 2; ++bj)
#pragma unroll
                    for (int n = 0; n < 2; ++n) { const f32x4 v = acc[ai][bj][m][n] * inv; typedef unsigned u32x2 __attribute__((ext_vector_type(2))); u32x2 p; p.x = cvt_pk_bf16(v[0], v[1]); p.y = cvt_pk_bf16(v[2], v[3]); *(u32x2*)(rowp + bj * HALF + n * 16) = p; } }
        asm volatile("s_waitcnt lgkmcnt(0)" ::: "memory"); __builtin_amdgcn_s_barrier(); asm volatile("" ::: "memory");
    }
};
template <class Epi, class Sched, bool ALIGN_EPI = false, bool SP2 = false>
__device__ __forceinline__ void gemm_phase(PG8_LAS unsigned char* lds, const Gemm g, const Sched& S, const Epi& E) {
    int tid_ = threadIdx.x; asm volatile("" : "+v"(tid_));
    const int tid = tid_, wid = __builtin_amdgcn_readfirstlane(tid >> 6), lane = tid & 63, wr = wid >> 2, wc = wid & 3, fr = lane & 15, fq = lane >> 4;
    const int K = g.K, nt = K / BK;
    unsigned voffA[2], voffB[2];
#pragma unroll
    for (int i = 0; i < 2; ++i) { int R, C; stage_rc(tid * 16 + i * 8192, R, C); const int Rb = Epi::PERM ? ((R & ~31) + perm32(R & 31)) : R;
        voffA[i] = (unsigned)(R * g.lda + C) * 2u; voffB[i] = (unsigned)(Rb * g.ldb + C) * 2u; }
    const size_t kstep = (size_t)(BK * 2);
    const size_t hstepA = (size_t)HALF * g.lda * 2, hstepB = (size_t)HALF * g.ldb * 2;
    const size_t tstepA = 2 * hstepA, tstepB = 2 * hstepB;
    const unsigned ldsw = (unsigned)wid * 1024u;
    const int aoff = lds_byte(wr * 64 + fr, fq * 8), boff = lds_byte(wc * 32 + fr, fq * 8);
#define PG8_SA(b, h) (((b) * 2 + (h)) * HTB)
#define PG8_SB(b, h) ((4 + (b) * 2 + (h)) * HTB)
#define PG8_STAGE(bufoff, gbase, voff) do { _Pragma("unroll") for (int _i = 0; _i < 2; ++_i) \
        __builtin_amdgcn_global_load_lds((const unsigned*)((const char*)(gbase) + (voff)[_i]), (PG8_LAS unsigned*)(lds + (bufoff) + ldsw + _i * 8192), 16, 0, 0); } while (0)
#define PG8_LDA(dst, b, h) do { _Pragma("unroll") for (int m = 0; m < 4; ++m) _Pragma("unroll") for (int k = 0; k < 2; ++k) dst[m][k] = *(const PG8_LAS bf16x8*)(lds + PG8_SA(b, h) + aoff + m * 2048 + k * 1024); } while (0)
#define PG8_LDB(dst, b, h) do { _Pragma("unroll") for (int n = 0; n < 2; ++n) _Pragma("unroll") for (int k = 0; k < 2; ++k) dst[n][k] = *(const PG8_LAS bf16x8*)(lds + PG8_SB(b, h) + boff + n * 2048 + k * 1024); } while (0)
#define PG8_MMA(ai, bj, At, Bt) do { __builtin_amdgcn_s_setprio(1); _Pragma("unroll") for (int m = 0; m < 4; ++m) _Pragma("unroll") for (int n = 0; n < 2; ++n) _Pragma("unroll") for (int k = 0; k < 2; ++k) \
        acc[ai][bj][m][n] = __builtin_amdgcn_mfma_f32_16x16x32_bf16(Bt[n][k], At[m][k], acc[ai][bj][m][n], 0, 0, 0); __builtin_amdgcn_s_setprio(0); } while (0)
#define PG8_WAIT_V(n) asm volatile("s_waitcnt vmcnt(" #n ")" ::: "memory")
#define PG8_WAIT_L(n) asm volatile("s_waitcnt lgkmcnt(" #n ")" ::: "memory")
#define PG8_BAR __builtin_amdgcn_s_barrier()
#define PG8_SCHED __builtin_amdgcn_sched_barrier(0)
    Unit cur, nxt; int ui = 0;
    if (!S.next(0, cur)) return;
    f32x4 acc[2][2][4][2];
#pragma unroll
    for (int a = 0; a < 2; ++a)
#pragma unroll
        for (int b = 0; b < 2; ++b)
#pragma unroll
            for (int m = 0; m < 4; ++m)
#pragma unroll
                for (int n = 0; n < 2; ++n) acc[a][b][m][n] = (f32x4){0.f, 0.f, 0.f, 0.f};
    bf16x8 At[4][2], B0[2][2], B1[2][2];
    const char* cA = (const char*)g.A + (size_t)cur.pm * tstepA; const char* cB = (const char*)g.Bt + (size_t)cur.pn * tstepB;
    S.a_ready(cur);
    if constexpr (SP2) {
        PG8_STAGE(PG8_SB(0, 0), cB, voffB); PG8_STAGE(PG8_SB(0, 1), cB + hstepB, voffB); PG8_STAGE(PG8_SA(0, 0), cA, voffA); PG8_STAGE(PG8_SA(0, 1), cA + hstepA, voffA);
        if (wr == 1) PG8_BAR;
        PG8_WAIT_V(2); PG8_BAR;
        PG8_STAGE(PG8_SB(1, 0), cB + kstep, voffB); PG8_STAGE(PG8_SA(1, 0), cA + kstep, voffA); PG8_STAGE(PG8_SB(1, 1), cB + hstepB + kstep, voffB);
        PG8_WAIT_V(6); PG8_BAR;
    } else {
        PG8_STAGE(PG8_SB(0, 0), cB, voffB); PG8_STAGE(PG8_SA(0, 0), cA, voffA); PG8_STAGE(PG8_SB(0, 1), cB + hstepB, voffB); PG8_STAGE(PG8_SA(0, 1), cA + hstepA, voffA);
        if (wr == 1) PG8_BAR;
        PG8_WAIT_V(4); PG8_BAR;
        PG8_STAGE(PG8_SB(1, 0), cB + kstep, voffB); PG8_STAGE(PG8_SA(1, 0), cA + kstep, voffA); PG8_STAGE(PG8_SB(1, 1), cB + hstepB + kstep, voffB);
        PG8_WAIT_V(6); PG8_BAR;
    }
    for (;;) {
        const bool has_next = S.next(ui + 1, nxt);
        const char* nA = has_next ? (const char*)g.A + (size_t)nxt.pm * tstepA : cA; const char* nB = has_next ? (const char*)g.Bt + (size_t)nxt.pn * tstepB : cB;
        for (int t = 0; t < nt; t += 2) {
            const bool last = (t == nt - 2);
            const char* a1 = cA + (size_t)(t + 1) * kstep;
            const char* a2 = last ? nA : cA + (size_t)(t + 2) * kstep; const char* b2 = last ? nB : cB + (size_t)(t + 2) * kstep;
            const char* a3 = a2 + kstep; const char* b3 = b2 + kstep;
            if (last && has_next) S.a_ready(nxt);
            if constexpr (SP2) {
            PG8_LDB(B0, 0, 0); PG8_LDB(B1, 0, 1); PG8_SCHED; PG8_LDA(At, 0, 0); PG8_STAGE(PG8_SA(1, 1), a1 + hstepA, voffA);
            PG8_WAIT_V(8); PG8_WAIT_L(0); PG8_BAR; PG8_MMA(0, 0, At, B0); PG8_MMA(0, 1, At, B1); PG8_BAR; PG8_SCHED;
            PG8_LDA(At, 0, 1); PG8_STAGE(PG8_SB(0, 0), b2, voffB); PG8_STAGE(PG8_SB(0, 1), b2 + hstepB, voffB); PG8_STAGE(PG8_SA(0, 0), a2, voffA);
            PG8_WAIT_V(8); PG8_WAIT_L(0); PG8_BAR; PG8_MMA(1, 0, At, B0); PG8_MMA(1, 1, At, B1); PG8_BAR; PG8_SCHED;
            PG8_LDB(B0, 1, 0); PG8_LDB(B1, 1, 1); PG8_SCHED; PG8_LDA(At, 1, 0); PG8_STAGE(PG8_SA(0, 1), a2 + hstepA, voffA);
            PG8_WAIT_V(8); PG8_WAIT_L(0); PG8_BAR; PG8_MMA(0, 0, At, B0); PG8_MMA(0, 1, At, B1); PG8_BAR; PG8_SCHED;
            PG8_LDA(At, 1, 1); PG8_STAGE(PG8_SB(1, 0), b3, voffB); PG8_STAGE(PG8_SB(1, 1), b3 + hstepB, voffB); PG8_STAGE(PG8_SA(1, 0), a3, voffA);
            PG8_WAIT_V(8); PG8_WAIT_L(0); PG8_BAR; PG8_MMA(1, 0, At, B0); PG8_MMA(1, 1, At, B1); PG8_BAR; PG8_SCHED;
            } else {
            PG8_LDB(B0, 0, 0); PG8_SCHED; PG8_LDA(At, 0, 0); PG8_STAGE(PG8_SA(1, 1), a1 + hstepA, voffA);
            PG8_WAIT_L(8); PG8_BAR; PG8_WAIT_L(0); PG8_MMA(0, 0, At, B0); PG8_BAR; PG8_SCHED;
            PG8_LDB(B1, 0, 1); PG8_STAGE(PG8_SB(0, 0), b2, voffB);
            PG8_BAR; PG8_WAIT_L(0); PG8_MMA(0, 1, At, B1); PG8_BAR;
            PG8_LDA(At, 0, 1); PG8_STAGE(PG8_SA(0, 0), a2, voffA);
            PG8_BAR; PG8_WAIT_L(0); PG8_MMA(1, 0, At, B0); PG8_BAR; PG8_SCHED;
            PG8_STAGE(PG8_SB(0, 1), b2 + hstepB, voffB);
            PG8_WAIT_V(6); PG8_BAR; PG8_MMA(1, 1, At, B1); PG8_BAR;
            PG8_LDB(B0, 1, 0); PG8_SCHED; PG8_LDA(At, 1, 0); PG8_STAGE(PG8_SA(0, 1), a2 + hstepA, voffA);
            PG8_WAIT_L(8); PG8_BAR; PG8_WAIT_L(0); PG8_MMA(0, 0, At, B0); PG8_BAR; PG8_SCHED;
            PG8_LDB(B1, 1, 1); PG8_STAGE(PG8_SB(1, 0), b3, voffB);
            PG8_BAR; PG8_WAIT_L(0); PG8_MMA(0, 1, At, B1); PG8_BAR;
            PG8_LDA(At, 1, 1); PG8_STAGE(PG8_SA(1, 0), a3, voffA);
            PG8_BAR; PG8_WAIT_L(0); PG8_MMA(1, 0, At, B0); PG8_BAR; PG8_SCHED;
            PG8_STAGE(PG8_SB(1, 1), b3 + hstepB, voffB);
            PG8_WAIT_V(6); PG8_BAR; PG8_MMA(1, 1, At, B1); PG8_BAR;
            }
        }
        if constexpr (ALIGN_EPI) { if (wr == 0) PG8_BAR; }
        if constexpr (!Epi::AFTER_DRAIN) { E(acc, cur, wr, wc, fr, fq); S.done(cur); }
        if (!has_next) break;
#pragma unroll
        for (int a = 0; a < 2; ++a)
#pragma unroll
            for (int b = 0; b < 2; ++b)
#pragma unroll
                for (int m = 0; m < 4; ++m)
#pragma unroll
                    for (int n = 0; n < 2; ++n) acc[a][b][m][n] = (f32x4){0.f, 0.f, 0.f, 0.f};
        cur = nxt; cA = nA; cB = nB; ++ui;
        if constexpr (ALIGN_EPI) { if (wr == 1) PG8_BAR; }
    }
    PG8_WAIT_V(0);
    if constexpr (!ALIGN_EPI) { if (wr == 0) PG8_BAR; }
    PG8_BAR;
    if constexpr (Epi::AFTER_DRAIN) { E.fused(acc, cur, wr, wc, fr, fq, lds, wid, lane); S.done(cur); }
#undef PG8_SA
#undef PG8_SB
#undef PG8_STAGE
#undef PG8_LDA
#undef PG8_LDB
#undef PG8_MMA
#undef PG8_WAIT_V
#undef PG8_WAIT_L
#undef PG8_BAR
#undef PG8_SCHED
}
}
#ifndef PG8_SP2
#define PG8_SP2 true
#endif
#ifndef PG8_ALIGN
#define PG8_ALIGN true
#endif
#define LAS __attribute__((address_space(3)))
#define GAS __attribute__((address_space(1)))
typedef unsigned short bf16;
typedef unsigned v4u __attribute__((ext_vector_type(4)));
typedef unsigned v2u __attribute__((ext_vector_type(2)));
typedef float f32x4 __attribute__((ext_vector_type(4)));
typedef short bf16x8 __attribute__((ext_vector_type(8)));

constexpr int NWAVES = 8;
constexpr int BATCH = 2, SEQ = 8192, DM = 1024, M = BATCH * SEQ, NMEM = 256, DFF = 2816, HFF = DFF / 2  , INC = 3080;
constexpr float LOG2E = 1.4426950408889634f;
constexpr float EPS = 1e-6f;

__device__ __forceinline__ unsigned f2bf(float f) { unsigned u = __builtin_bit_cast(unsigned, f); return (u + 0x7fffu + ((u >> 16) & 1u)) >> 16; }
__device__ __forceinline__ unsigned pk2(float lo, float hi) { return f2bf(lo) | (f2bf(hi) << 16); }
__device__ __forceinline__ float bflo(unsigned w) { return __builtin_bit_cast(float, w << 16); }
__device__ __forceinline__ float bfhi(unsigned w) { return __builtin_bit_cast(float, w & 0xffff0000u); }
__device__ __forceinline__ float wave_sum(float v) {
#pragma unroll
    for (int o = 1; o < 64; o <<= 1) v += __shfl_xor(v, o);
    return v;
}
__device__ __forceinline__ float wave_max(float v) {
#pragma unroll
    for (int o = 1; o < 64; o <<= 1) v = fmaxf(v, __shfl_xor(v, o));
    return v;
}

namespace att {
typedef short s16x4 __attribute__((ext_vector_type(4)));
typedef float f32x16 __attribute__((ext_vector_type(16)));
typedef float f32x2_t __attribute__((ext_vector_type(2)));
typedef __bf16 bf16x2_t __attribute__((ext_vector_type(2)));
constexpr int KP = 144, VP = 144;
constexpr int OFF_K = 0, OFF_V = 2 * 64 * KP, OFF_C = OFF_V + 2 * 64 * VP, OFF_F = OFF_C + 512, LDS_BYTES = OFF_F + 64;
constexpr int QKLD = 2048, VTLD = 16384;
__device__ __forceinline__ unsigned cvtpk(float lo, float hi) { f32x2_t v = {lo, hi}; bf16x2_t b = __builtin_convertvector(v, bf16x2_t); return __builtin_bit_cast(unsigned, b); }
__device__ __forceinline__ float ex2(float x) { return __builtin_amdgcn_exp2f(x); }
__device__ __forceinline__ float lg2(float x) { return __builtin_amdgcn_logf(x); }

template <int MODE>
__device__ __forceinline__ bool tile_step(int it, int NT, int tw, int qq, int hi, int r32, int w, int lane, int tid, int srow, int sch, LAS unsigned char* lds,
                                          const bf16* kst, const bf16* vst, const float* Cg, const bf16x8 (&qr)[4], float cq,
                                          v4u& kreg, v4u& vreg, f32x4& creg, f32x16& o0, f32x16& o1, float& mrun, float& lsum, float& R) {
    const int t = NT - 1 - it, bufi = it & 1;
    LAS unsigned char* Kb = lds + OFF_K + bufi * 64 * KP; LAS unsigned char* Vb = lds + OFF_V + bufi * 64 * VP; LAS unsigned char* Cb = lds + OFF_C + bufi * 256;
    LAS unsigned* flags = (LAS unsigned*)(lds + OFF_F);
    *(LAS v4u*)(Kb + srow * KP + sch * 16) = kreg; *(LAS v4u*)(Vb + srow * VP + sch * 16) = vreg;
    if (MODE == 0 && tid < 16) *(LAS f32x4*)(Cb + tid * 16) = creg;
    __syncthreads();
    if (MODE == 1 && it > 0) {
        const v4u fa = *(LAS v4u*)(flags + ((it - 1) & 1) * 8), fb = *(LAS v4u*)(flags + ((it - 1) & 1) * 8 + 4);
        if ((fa.x & fa.y & fa.z & fa.w & fb.x & fb.y & fb.z & fb.w) != 0u) return true;
    }
    if (t >= 3) { const int tn = t - 3; kreg = *(const v4u*)(kst + (size_t)tn * 64 * QKLD); vreg = *(const v4u*)(vst + tn * 64); if (MODE == 0 && tid < 16) creg = *(const f32x4*)(Cg + tn * 64 + tid * 4); }
    if (t <= tw) {
        f32x16 p0, p1;
        bf16x8 kf0[4], kf1[4]; f32x4 cv0[4], cv1[4];
#pragma unroll
        for (int d0 = 0; d0 < 4; ++d0) { kf0[d0] = *(LAS bf16x8*)(Kb + r32 * KP + d0 * 32 + hi * 16); kf1[d0] = *(LAS bf16x8*)(Kb + (32 + r32) * KP + d0 * 32 + hi * 16); }
        if (MODE == 0) {
#pragma unroll
            for (int rg = 0; rg < 4; ++rg) { cv0[rg] = *(LAS f32x4*)(Cb + (8 * rg + 4 * hi) * 4); cv1[rg] = *(LAS f32x4*)(Cb + (32 + 8 * rg + 4 * hi) * 4); }
        }
        asm volatile("s_waitcnt lgkmcnt(0)" ::: "memory");
        if (MODE == 0) {
#pragma unroll
            for (int rg = 0; rg < 4; ++rg)
#pragma unroll
                for (int i = 0; i < 4; ++i) { p0[4 * rg + i] = cq - cv0[rg][i]; p1[4 * rg + i] = cq - cv1[rg][i]; }
        } else {
#pragma unroll
            for (int r = 0; r < 16; ++r) { p0[r] = 0.f; p1[r] = 0.f; }
        }
#pragma unroll
        for (int d0 = 0; d0 < 4; ++d0) {
            p0 = __builtin_amdgcn_mfma_f32_32x32x16_bf16(kf0[d0], qr[d0], p0, 0, 0, 0);
            p1 = __builtin_amdgcn_mfma_f32_32x32x16_bf16(kf1[d0], qr[d0], p1, 0, 0, 0);
        }
        const bool diag = (t == tw);
        if (MODE == 0) {
            if (diag) {
#pragma unroll
                for (int r = 0; r < 16; ++r) { const int kk = (r & 3) + 8 * (r >> 2) + 4 * hi; if (kk > qq) p0[r] = -INFINITY; if (kk + 32 > qq) p1[r] = -INFINITY; }
            }
            float rm = fmaxf(p0[0], p1[0]);
#pragma unroll
            for (int r = 1; r < 16; ++r) rm = fmaxf(rm, fmaxf(p0[r], p1[r]));
            { const auto rr = __builtin_amdgcn_permlane32_swap(__float_as_uint(rm), __float_as_uint(rm), false, false); rm = fmaxf(__uint_as_float(rr[0]), __uint_as_float(rr[1])); }
            if (__any(rm > mrun)) {
                const float mn = fmaxf(mrun, rm), al = ex2(mrun - mn);
                lsum *= al;
#pragma unroll
                for (int r = 0; r < 16; ++r) { o0[r] *= al; o1[r] *= al; }
                mrun = mn;
            }
            float s = 0.f;
#pragma unroll
            for (int r = 0; r < 16; ++r) { p0[r] = ex2(p0[r] - mrun); p1[r] = ex2(p1[r] - mrun); s += p0[r] + p1[r]; }
            lsum += s;
        } else {
            f32x16 x0, x1;
#pragma unroll
            for (int r = 0; r < 16; ++r) {
                x0[r] = p0[r] > 24.f ? p0[r] : lg2(1.f + ex2(p0[r]));
                x1[r] = p1[r] > 24.f ? p1[r] : lg2(1.f + ex2(p1[r]));
            }
            if (diag) {
#pragma unroll
                for (int r = 0; r < 16; ++r) { const int kk = (r & 3) + 8 * (r >> 2) + 4 * hi; if (kk >= qq) x0[r] = 0.f; if (kk + 32 >= qq) x1[r] = 0.f; }
            }
            float gs[8], ps[8], aft[8];
#pragma unroll
            for (int rg = 0; rg < 4; ++rg) { gs[rg] = (x0[4 * rg] + x0[4 * rg + 1]) + (x0[4 * rg + 2] + x0[4 * rg + 3]); gs[4 + rg] = (x1[4 * rg] + x1[4 * rg + 1]) + (x1[4 * rg + 2] + x1[4 * rg + 3]); }
#pragma unroll
            for (int i = 0; i < 8; ++i) ps[i] = __shfl_xor(gs[i], 32);
            float run = 0.f;
#pragma unroll
            for (int i = 7; i >= 0; --i) { aft[i] = run + (hi ? 0.f : ps[i]); run += gs[i] + ps[i]; }
#pragma unroll
            for (int rg = 0; rg < 4; ++rg) {
                float bs = R + aft[rg];
                x0[4 * rg + 3] += bs; x0[4 * rg + 2] += x0[4 * rg + 3]; x0[4 * rg + 1] += x0[4 * rg + 2]; x0[4 * rg] += x0[4 * rg + 1];
                bs = R + aft[4 + rg];
                x1[4 * rg + 3] += bs; x1[4 * rg + 2] += x1[4 * rg + 3]; x1[4 * rg + 1] += x1[4 * rg + 2]; x1[4 * rg] += x1[4 * rg + 1];
            }
            R += run;
#pragma unroll
            for (int r = 0; r < 16; ++r) { p0[r] = ex2(p0[r] - x0[r]); p1[r] = ex2(p1[r] - x1[r]); }
            if (diag) {
#pragma unroll
                for (int r = 0; r < 16; ++r) { const int kk = (r & 3) + 8 * (r >> 2) + 4 * hi; if (kk >= qq) p0[r] = 0.f; if (kk + 32 >= qq) p1[r] = 0.f; }
            }
        }
        s16x4 vl0[4], vh0[4], vl1[4], vh1[4];
#pragma unroll
        for (int ks = 0; ks < 4; ++ks) {
            vl0[ks] = *(LAS s16x4*)(Vb + r32 * VP + (16 * ks + 4 * hi) * 2); vh0[ks] = *(LAS s16x4*)(Vb + r32 * VP + (16 * ks + 8 + 4 * hi) * 2);
            vl1[ks] = *(LAS s16x4*)(Vb + (32 + r32) * VP + (16 * ks + 4 * hi) * 2); vh1[ks] = *(LAS s16x4*)(Vb + (32 + r32) * VP + (16 * ks + 8 + 4 * hi) * 2);
        }
        v4u pw[4];
#pragma unroll
        for (int j = 0; j < 2; ++j) {
            pw[j]     = (v4u){cvtpk(p0[8 * j], p0[8 * j + 1]), cvtpk(p0[8 * j + 2], p0[8 * j + 3]), cvtpk(p0[8 * j + 4], p0[8 * j + 5]), cvtpk(p0[8 * j + 6], p0[8 * j + 7])};
            pw[2 + j] = (v4u){cvtpk(p1[8 * j], p1[8 * j + 1]), cvtpk(p1[8 * j + 2], p1[8 * j + 3]), cvtpk(p1[8 * j + 4], p1[8 * j + 5]), cvtpk(p1[8 * j + 6], p1[8 * j + 7])};
        }
        asm volatile("s_waitcnt lgkmcnt(0)" ::: "memory");
#pragma unroll
        for (int ks = 0; ks < 4; ++ks) {
            const bf16x8 pa = __builtin_bit_cast(bf16x8, pw[ks]);
            const bf16x8 v0 = (bf16x8){vl0[ks][0], vl0[ks][1], vl0[ks][2], vl0[ks][3], vh0[ks][0], vh0[ks][1], vh0[ks][2], vh0[ks][3]};
            const bf16x8 v1 = (bf16x8){vl1[ks][0], vl1[ks][1], vl1[ks][2], vl1[ks][3], vh1[ks][0], vh1[ks][1], vh1[ks][2], vh1[ks][3]};
            o0 = __builtin_amdgcn_mfma_f32_32x32x16_bf16(v0, pa, o0, 0, 0, 0);
            o1 = __builtin_amdgcn_mfma_f32_32x32x16_bf16(v1, pa, o1, 0, 0, 0);
        }
    }
    if (MODE == 1) { const bool done = __all(R > 150.f); if (lane == 0) flags[bufi * 8 + w] = done ? 1u : 0u; }
    return false;
}

template <int MODE>
__device__ __forceinline__ void unit(int b, int h, int qb, const bf16* __restrict__ QK, const bf16* __restrict__ VT, const float* __restrict__ C2, bf16* __restrict__ AO, LAS unsigned char* lds) {
    int tid_ = threadIdx.x; asm volatile("" : "+v"(tid_));
    const int tid = tid_, lane = tid & 63, w = __builtin_amdgcn_readfirstlane(tid >> 6), r32 = lane & 31, hi = lane >> 5;
    const int q0 = qb * 256; const size_t rowbase = (size_t)b * SEQ;
    const bf16* Qp = QK + (rowbase + q0 + w * 32 + r32) * QKLD + MODE * 1024 + h * 64;
    const bf16* Kg = QK + rowbase * QKLD + MODE * 1024 + 512 + h * 64;
    const bf16* Vg = VT + (size_t)(MODE * 512 + h * 64) * VTLD + rowbase;
    const float* Cg = C2 + (size_t)(b * 8 + h) * SEQ;
    bf16x8 qr[4];
#pragma unroll
    for (int d0 = 0; d0 < 4; ++d0) qr[d0] = *(const bf16x8*)(Qp + d0 * 16 + hi * 8);
    const int srow = tid >> 3, sch = tid & 7;
    const bf16* kst = Kg + (size_t)srow * QKLD + sch * 8;
    const bf16* vst = Vg + (size_t)srow * VTLD + sch * 8;
    const int NT = 4 * qb + 4, tw = 4 * qb + (w >> 1);
    const int qq = 32 * (w & 1) + r32;
    v4u kA, vA, kB, vB, kC, vC; f32x4 cA = {0.f, 0.f, 0.f, 0.f}, cB = cA, cC = cA;
#define ATT_LD(KR, VR, CR, tt) do { KR = *(const v4u*)(kst + (size_t)(tt) * 64 * QKLD); VR = *(const v4u*)(vst + (tt) * 64); if (MODE == 0 && tid < 16) CR = *(const f32x4*)(Cg + (tt) * 64 + tid * 4); } while (0)
    ATT_LD(kA, vA, cA, NT - 1); ATT_LD(kB, vB, cB, NT - 2); ATT_LD(kC, vC, cC, NT - 3);
#undef ATT_LD
    float cq = 0.f; if (MODE == 0) cq = Cg[q0 + w * 32 + r32];
    float mrun = -1e30f, lsum = 0.f, R = 0.f;
    f32x16 o0, o1;
#pragma unroll
    for (int r = 0; r < 16; ++r) { o0[r] = 0.f; o1[r] = 0.f; }
    for (int it = 0; it < NT; it += 3) {
        if (tile_step<MODE>(it, NT, tw, qq, hi, r32, w, lane, tid, srow, sch, lds, kst, vst, Cg, qr, cq, kA, vA, cA, o0, o1, mrun, lsum, R)) break;
        if (it + 1 >= NT) break;
        if (tile_step<MODE>(it + 1, NT, tw, qq, hi, r32, w, lane, tid, srow, sch, lds, kst, vst, Cg, qr, cq, kB, vB, cB, o0, o1, mrun, lsum, R)) break;
        if (it + 2 >= NT) break;
        if (tile_step<MODE>(it + 2, NT, tw, qq, hi, r32, w, lane, tid, srow, sch, lds, kst, vst, Cg, qr, cq, kC, vC, cC, o0, o1, mrun, lsum, R)) break;
    }
    float inv = 1.f;
    if (MODE == 0) { const auto rr = __builtin_amdgcn_permlane32_swap(__float_as_uint(lsum), __float_as_uint(lsum), false, false); inv = 1.f / (__uint_as_float(rr[0]) + __uint_as_float(rr[1])); }
    bf16* Op = AO + (rowbase + q0 + w * 32 + r32) * 1024 + MODE * 512 + h * 64 + 4 * hi;
#pragma unroll
    for (int rg = 0; rg < 4; ++rg) {
        v2u a, c;
        a.x = cvtpk(o0[4 * rg] * inv, o0[4 * rg + 1] * inv); a.y = cvtpk(o0[4 * rg + 2] * inv, o0[4 * rg + 3] * inv);
        c.x = cvtpk(o1[4 * rg] * inv, o1[4 * rg + 1] * inv); c.y = cvtpk(o1[4 * rg + 2] * inv, o1[4 * rg + 3] * inv);
        *(v2u*)(Op + 8 * rg) = a; *(v2u*)(Op + 32 + 8 * rg) = c;
    }
    __syncthreads();
}
}
constexpr size_t MiB = 1u << 20;
constexpr size_t WS_WQK = 1 * MiB, WS_WV = 5 * MiB, WS_WOUT = 7 * MiB, WS_WMQN = 9 * MiB, WS_WMKV = 11 * MiB, WS_WMO = 15 * MiB, WS_WUP = 17 * MiB, WS_WDOWN = 28 * MiB;
constexpr size_t WS_BAR = 0, BAR_ZERO_BYTES = 65536;
constexpr size_t WS_MN = 34 * MiB, WS_KVM = 35 * MiB, WS_WK = 37 * MiB, WS_VW = 41 * MiB, WS_LF = 45 * MiB, WS_C2 = 46 * MiB, WS_PS = 47 * MiB;
constexpr size_t WS_H = 48 * MiB, WS_QK = 80 * MiB, WS_VT = 144 * MiB, WS_AO = 176 * MiB;
constexpr size_t WS_S = 80 * MiB, WS_P = 144 * MiB, WS_U = 80 * MiB, WS_ACT = 168 * MiB, WS_END = 256 * MiB;
static_assert(WS_U + (size_t)M * DFF * 2 <= WS_ACT && WS_ACT + (size_t)M * DFF * 2 <= WS_END, "d_ws map");

constexpr int LDS_BYTES = 147456;
constexpr int NSTEPS = 13;

struct Args { const float* in[19]; float* out; unsigned char* ws; int ph_lo, ph_hi; };

struct Ctx {
    LAS unsigned char* lds;
    int tid, lane, wave, vcu, G;
    float* out; unsigned char* ws;
};
constexpr int PARAM_OFF = 131072;
__device__ __forceinline__ const float* inp(const Ctx& F, int k) {
    volatile LAS unsigned* p = (volatile LAS unsigned*)(F.lds + PARAM_OFF) + 2 * k;
    const unsigned lo = __builtin_amdgcn_readfirstlane(p[0]), hi = __builtin_amdgcn_readfirstlane(p[1]);
    return (const float*)(GAS const float*)(((unsigned long long)hi << 32) | (unsigned long long)lo);
}

__device__ __forceinline__ void transpose_item(const float* __restrict__ W, int ldw, int c0, int ncols, bf16* __restrict__ WT, int ldt, int row_off, float scale, LAS float* scr, int item, int lane) {
    const int nblk = ncols / 32, kb = item / nblk, nb = item % nblk, k0 = 64 * kb, n0 = 32 * nb;
#pragma unroll
    for (int i = 0; i < 32; ++i) { const int kk = 2 * i + (lane >> 5); scr[kk * 33 + (lane & 31)] = W[(size_t)(k0 + kk) * ldw + c0 + n0 + (lane & 31)] * scale; }
    asm volatile("s_waitcnt lgkmcnt(0)" ::: "memory");
    const int c = lane & 7;
#pragma unroll
    for (int j = 0; j < 4; ++j) { const int n = (lane >> 3) + 8 * j; const LAS float* s = scr + (8 * c) * 33 + n;
        v4u o; o.x = pk2(s[0 * 33], s[1 * 33]); o.y = pk2(s[2 * 33], s[3 * 33]); o.z = pk2(s[4 * 33], s[5 * 33]); o.w = pk2(s[6 * 33], s[7 * 33]);
        *(v4u*)(WT + (size_t)(row_off + n0 + n) * ldt + k0 + 8 * c) = o; }
    asm volatile("s_waitcnt lgkmcnt(0)" ::: "memory");
}

__device__ __forceinline__ void rms_row_to_bf16(const float* __restrict__ xrow, const float* __restrict__ g, bf16* __restrict__ orow, int lane, f32x4 (&v)[4]) {
    const f32x4* xr = (const f32x4*)xrow + lane; const f32x4* gr = (const f32x4*)g + lane;
    float s2 = 0.f;
#pragma unroll
    for (int j = 0; j < 4; ++j) { v[j] = xr[64 * j]; s2 += (v[j].x * v[j].x + v[j].y * v[j].y) + (v[j].z * v[j].z + v[j].w * v[j].w); }
    const float rstd = 1.0f / sqrtf(wave_sum(s2) * (1.f / DM) + EPS);
    unsigned long long* o8 = (unsigned long long*)orow + lane;
#pragma unroll
    for (int j = 0; j < 4; ++j) { const f32x4 gg = gr[64 * j]; v[j] = v[j] * rstd * gg;
        o8[64 * j] = (unsigned long long)pk2(v[j].x, v[j].y) | ((unsigned long long)pk2(v[j].z, v[j].w) << 32); }
}

__device__ __forceinline__ float log_sigmoid(float x) { return fminf(x, 0.f) - log1pf(expf(-fabsf(x))); }

__device__ __forceinline__ void step_prologue(const Ctx& F) {
    LAS float* scr = (LAS float*)(F.lds + F.wave * 16384);
    const int gw = F.vcu * NWAVES + F.wave, NGW = F.G * NWAVES;
    unsigned char* ws = F.ws;
    const float* w_in = inp(F, 3);
    const float QS = 0.125f * LOG2E;
    constexpr int I_IN = 16 * 16, I_OUT = 16 * 32, I_MKV = 16 * 64, I_MO = 16 * 32, I_UP = 16 * 44, I_DN = 44 * 32;
    constexpr int NITEMS = 6 * I_IN + I_OUT + I_MKV + I_MO + 4 * I_UP + I_DN;
    for (int it = gw; it < NITEMS; it += NGW) {
        int r = it;
        if (r < 6 * I_IN) { const int blk = r / I_IN; r -= blk * I_IN;
            bf16* dst = (blk == 2 || blk == 5) ? (bf16*)(ws + WS_WV) : (bf16*)(ws + WS_WQK);
            const int row_off = (blk == 0) ? 0 : (blk == 1) ? 512 : (blk == 2) ? 0 : (blk == 3) ? 1024 : (blk == 4) ? 1536 : 512;
            const float sc = (blk == 0 || blk == 3) ? QS : 1.f;
            transpose_item(w_in, INC, blk * 512, 512, dst, DM, row_off, sc, scr, r, F.lane); continue; }
        r -= 6 * I_IN;
        if (r < I_OUT) { transpose_item(inp(F, 7), DM, 0, DM, (bf16*)(ws + WS_WOUT), DM, 0, 1.f, scr, r, F.lane); continue; } r -= I_OUT;
        if (r < I_MKV) { transpose_item(inp(F, 11), 2 * DM, 0, 2 * DM, (bf16*)(ws + WS_WMKV), DM, 0, 1.f, scr, r, F.lane); continue; } r -= I_MKV;
        if (r < I_MO) { transpose_item(inp(F, 12), DM, 0, DM, (bf16*)(ws + WS_WMO), DM, 0, 1.f, scr, r, F.lane); continue; } r -= I_MO;
        if (r < 4 * I_UP) { const int blk = r / I_UP; r -= blk * I_UP;
            const int c0 = (blk == 0) ? 0 : (blk == 1) ? DFF : (blk == 2) ? HFF : DFF + HFF;
            transpose_item(inp(F, 14), 2 * DFF, c0, HFF, (bf16*)(ws + WS_WUP), DM, blk * HFF, 1.f, scr, r, F.lane); continue; }
        r -= 4 * I_UP;
        transpose_item(inp(F, 17), DM, 0, DM, (bf16*)(ws + WS_WDOWN), DFF, 0, 1.f, scr, r, F.lane);
    }
    { const float* wq = inp(F, 10); bf16* dq = (bf16*)(ws + WS_WMQN); const float sc = 0.0625f * LOG2E;
      for (int i = (F.vcu * 512 + F.tid); i < DM * DM / 4; i += F.G * 512) { const f32x4 v = ((const f32x4*)wq)[i]; v2u o; o.x = pk2(v.x * sc, v.y * sc); o.y = pk2(v.z * sc, v.w * sc); ((v2u*)dq)[i] = o; } }
    { const float* x = inp(F, 0); const float* g = inp(F, 2); const float* bfg = inp(F, 4); bf16* H = (bf16*)(ws + WS_H); float* LF = (float*)(ws + WS_LF);
      LAS float* wf = (LAS float*)F.lds;
      __syncthreads();
#pragma unroll
      for (int kk = 0; kk < 2; ++kk) { const int k = F.tid + 512 * kk; const f32x4 wa = *(const f32x4*)(w_in + (size_t)k * INC + 3072), wb = *(const f32x4*)(w_in + (size_t)k * INC + 3076);
          wf[k] = wa.x; wf[1024 + k] = wa.y; wf[2048 + k] = wa.z; wf[3072 + k] = wa.w; wf[4096 + k] = wb.x; wf[5120 + k] = wb.y; wf[6144 + k] = wb.z; wf[7168 + k] = wb.w; }
      __syncthreads();
      for (int m = gw; m < M; m += NGW) {
          f32x4 v[4]; rms_row_to_bf16(x + (size_t)m * DM, g, H + (size_t)m * DM, F.lane, v);
          float acc[8];
#pragma unroll
          for (int j8 = 0; j8 < 8; ++j8) { float a = 0.f;
#pragma unroll
              for (int j = 0; j < 4; ++j) { const f32x4 wv = *(LAS f32x4*)(wf + j8 * 1024 + 4 * F.lane + 256 * j); a += (v[j].x * wv.x + v[j].y * wv.y) + (v[j].z * wv.z + v[j].w * wv.w); }
              acc[j8] = wave_sum(a); }
          if (F.lane < 8) { float a = acc[0];
#pragma unroll
              for (int j = 1; j < 8; ++j) a = (F.lane == j) ? acc[j] : a;
              const int bb = m / SEQ, s = m % SEQ; LF[(size_t)(bb * 8 + F.lane) * SEQ + s] = log_sigmoid(a + bfg[F.lane]); }
      } }
    { const float* mem = inp(F, 1); const float* g = inp(F, 9); bf16* MN = (bf16*)(ws + WS_MN);
      for (int m = gw; m < BATCH * NMEM; m += NGW) { f32x4 v[4]; rms_row_to_bf16(mem + (size_t)m * DM, g, MN + (size_t)m * DM, F.lane, v); } }
}

__device__ __forceinline__ void step_scan(const Ctx& F) {
    if (blockIdx.x >= 16) return;
    const int seq = blockIdx.x;
    const size_t off = (size_t)seq * SEQ + F.wave * 1024 + F.lane * 16;
    const float* src = (const float*)(F.ws + WS_LF) + off; float* dst = (float*)(F.ws + WS_C2) + off;
    float v[16];
#pragma unroll
    for (int i = 0; i < 4; ++i) { const f32x4 t = ((const f32x4*)src)[i]; v[4 * i] = t.x; v[4 * i + 1] = t.y; v[4 * i + 2] = t.z; v[4 * i + 3] = t.w; }
#pragma unroll
    for (int i = 1; i < 16; ++i) v[i] += v[i - 1];
    const float tot = v[15]; float inc = tot;
#pragma unroll
    for (int o = 1; o < 64; o <<= 1) { const float u = __shfl_up(inc, o); if (F.lane >= o) inc += u; }
    LAS float* wt = (LAS float*)(F.lds + 65536);
    if (F.lane == 63) wt[F.wave] = inc;
    __syncthreads();
    float pre = inc - tot;
    for (int w2 = 0; w2 < F.wave; ++w2) pre += wt[w2];
#pragma unroll
    for (int i = 0; i < 4; ++i) { f32x4 o; o.x = (pre + v[4 * i]) * LOG2E; o.y = (pre + v[4 * i + 1]) * LOG2E; o.z = (pre + v[4 * i + 2]) * LOG2E; o.w = (pre + v[4 * i + 3]) * LOG2E; ((f32x4*)dst)[i] = o; }
}

__device__ __forceinline__ void step_mixnorm(const Ctx& F) {
    const int gw = F.vcu * NWAVES + F.wave, NGW = F.G * NWAVES; bf16* AO = (bf16*)(F.ws + WS_AO);
    const float* gf = inp(F, 5); const float* gs = inp(F, 6);
    for (int m = gw; m < M; m += NGW) {
        v4u* row = (v4u*)(AO + (size_t)m * DM) + F.lane;
#pragma unroll
        for (int hf = 0; hf < 2; ++hf) {
            const v4u w = row[64 * hf]; float v[8];
            v[0] = bflo(w.x); v[1] = bfhi(w.x); v[2] = bflo(w.y); v[3] = bfhi(w.y); v[4] = bflo(w.z); v[5] = bfhi(w.z); v[6] = bflo(w.w); v[7] = bfhi(w.w);
            float s2 = 0.f;
#pragma unroll
            for (int e = 0; e < 8; ++e) s2 += v[e] * v[e];
            const float rstd = 1.0f / sqrtf(wave_sum(s2) * (1.f / 512.f) + EPS);
            const float* g = (hf ? gs : gf) + 8 * F.lane; const f32x4 ga = *(const f32x4*)g, gb = *(const f32x4*)(g + 4);
            v4u o; o.x = pk2(v[0] * rstd * ga.x, v[1] * rstd * ga.y); o.y = pk2(v[2] * rstd * ga.z, v[3] * rstd * ga.w); o.z = pk2(v[4] * rstd * gb.x, v[5] * rstd * gb.y); o.w = pk2(v[6] * rstd * gb.z, v[7] * rstd * gb.w);
            row[64 * hf] = o;
        }
    }
}


__device__ __forceinline__ void step_final(const Ctx& F) {
    const int gw = F.vcu * NWAVES + F.wave, NGW = F.G * NWAVES; const float* g = inp(F, 18);
    for (int m = gw; m < M; m += NGW) {
        f32x4* xr = (f32x4*)(F.out + (size_t)m * DM) + F.lane; const f32x4* gr = (const f32x4*)g + F.lane; f32x4 v[4]; float s2 = 0.f;
#pragma unroll
        for (int j = 0; j < 4; ++j) { v[j] = xr[64 * j]; s2 += (v[j].x * v[j].x + v[j].y * v[j].y) + (v[j].z * v[j].z + v[j].w * v[j].w); }
        const float rstd = 1.0f / sqrtf(wave_sum(s2) * (1.f / DM) + EPS);
#pragma unroll
        for (int j = 0; j < 4; ++j) xr[64 * j] = v[j] * rstd * gr[64 * j];
    }
}


__device__ __forceinline__ void unpack8(const v4u a, float (&o)[8]) { o[0] = bflo(a.x); o[1] = bfhi(a.x); o[2] = bflo(a.y); o[3] = bfhi(a.y); o[4] = bflo(a.z); o[5] = bfhi(a.z); o[6] = bflo(a.w); o[7] = bfhi(a.w); }
__device__ __forceinline__ void step_conv(const Ctx& F, int half) {
    const bf16* U = (const bf16*)(F.ws + WS_U); bf16* ACT = (bf16*)(F.ws + WS_ACT); const float* cw = inp(F, 15); const float* cb = inp(F, 16);
    constexpr int NCC = HFF / 8  , NRC = M / 8, NIT = NCC * NRC;
    for (int item = F.vcu * 512 + F.tid; item < NIT; item += F.G * 512) {
        const int cc = item % NCC, rc = item / NCC, t0 = rc * 8, j0 = cc * 8, fg = half * HFF + j0, fv = DFF + fg;
        const bool first = (t0 % SEQ) == 0;
        v4u ug[10], uv[10];
#pragma unroll
        for (int rr = 0; rr < 10; ++rr) {
            if (rr < 2 && first) { ug[rr] = (v4u){0u, 0u, 0u, 0u}; uv[rr] = (v4u){0u, 0u, 0u, 0u}; }
            else { const size_t t = (size_t)(t0 - 2 + rr); ug[rr] = *(const v4u*)(U + t * DFF + j0); uv[rr] = *(const v4u*)(U + t * DFF + HFF + j0); }
        }
        float wg[3][8], wv[3][8], bg[8], bv[8];
#pragma unroll
        for (int i = 0; i < 3; ++i)
#pragma unroll
            for (int e = 0; e < 8; e += 4) { const f32x4 a = *(const f32x4*)(cw + (size_t)i * 2 * DFF + fg + e), c = *(const f32x4*)(cw + (size_t)i * 2 * DFF + fv + e);
                wg[i][e] = a.x; wg[i][e + 1] = a.y; wg[i][e + 2] = a.z; wg[i][e + 3] = a.w; wv[i][e] = c.x; wv[i][e + 1] = c.y; wv[i][e + 2] = c.z; wv[i][e + 3] = c.w; }
#pragma unroll
        for (int e = 0; e < 8; e += 4) { const f32x4 a = *(const f32x4*)(cb + fg + e), c = *(const f32x4*)(cb + fv + e);
            bg[e] = a.x; bg[e + 1] = a.y; bg[e + 2] = a.z; bg[e + 3] = a.w; bv[e] = c.x; bv[e + 1] = c.y; bv[e + 2] = c.z; bv[e + 3] = c.w; }
        float g2[8], g1[8], v2[8], v1[8];
        unpack8(ug[0], g2); unpack8(ug[1], g1); unpack8(uv[0], v2); unpack8(uv[1], v1);
#pragma unroll
        for (int rr = 0; rr < 8; ++rr) {
            float g0[8], v0[8], o[8];
            unpack8(ug[rr + 2], g0); unpack8(uv[rr + 2], v0);
#pragma unroll
            for (int e = 0; e < 8; ++e) {
                const float gt = bg[e] + wg[0][e] * g2[e] + wg[1][e] * g1[e] + wg[2][e] * g0[e];
                const float vl = bv[e] + wv[0][e] * v2[e] + wv[1][e] * v1[e] + wv[2][e] * v0[e];
                o[e] = gt / (1.f + __expf(-gt)) * vl;
                g2[e] = g1[e]; g1[e] = g0[e]; v2[e] = v1[e]; v1[e] = v0[e];
            }
            v4u ov; ov.x = pk2(o[0], o[1]); ov.y = pk2(o[2], o[3]); ov.z = pk2(o[4], o[5]); ov.w = pk2(o[6], o[7]);
            *(v4u*)(ACT + (size_t)(t0 + rr) * DFF + fg) = ov;
        }
    }
}

__device__ __forceinline__ void step_attention(const Ctx& F) {
    const bf16* QK = (const bf16*)(F.ws + WS_QK); const bf16* VT = (const bf16*)(F.ws + WS_VT); const float* C2 = (const float*)(F.ws + WS_C2); bf16* AO = (bf16*)(F.ws + WS_AO);
#if defined(PROBE_FOX2)
    const int nfox = 1024;
#else
    const int nfox = 512;
#endif
#if defined(PROBE_SB2)
    const int nsb = 1024;
#else
    const int nsb = 512;
#endif
#pragma nounroll
    for (int id0 = F.vcu; id0 < nfox; id0 += F.G) { const int id = id0 & 511, v = id & 255, bh = v >> 4, s = v & 15, qb = (id >> 8) ? 31 - s : s; att::unit<0>(bh >> 3, bh & 7, qb, QK, VT, C2, AO, F.lds); }
#pragma nounroll
    for (int id0 = F.vcu; id0 < nsb; id0 += F.G) { const int id = id0 & 511, v = id & 255, bh = v >> 4, s = v & 15, qb = (id >> 8) ? 31 - s : s; att::unit<1>(bh >> 3, bh & 7, qb, QK, VT, C2, AO, F.lds); }
}

struct Job { pg8::Gemm g; int G, c; bf16* O; int ldc; const float* base; float* out; bf16* hn; const float* gn; float* ps_out; const float* ps_in; };

__device__ __forceinline__ bool bf16_job(const Ctx& F, int step, int j, Job& J) {
    unsigned char* ws = F.ws; const int bx = (int)blockIdx.x;
    J.G = F.G; J.c = bx; J.ps_in = nullptr;
    if (step == 1) {
        if (j == 0) { J.g = pg8::Gemm{(const bf16*)(ws + WS_MN), (const bf16*)(ws + WS_WMKV), BATCH * NMEM, 2 * DM, DM, DM, DM}; J.O = (bf16*)(ws + WS_KVM); J.ldc = 2 * DM; return true; }
        if (j == 1) { J.g = pg8::Gemm{(const bf16*)(ws + WS_H), (const bf16*)(ws + WS_WQK), M, 2048, DM, DM, DM}; J.O = (bf16*)(ws + WS_QK); J.ldc = 2048; return true; }
        if (j == 2) { J.g = pg8::Gemm{(const bf16*)(ws + WS_WV), (const bf16*)(ws + WS_H), DM, M, DM, DM, DM}; J.O = (bf16*)(ws + WS_VT); J.ldc = M; return true; }
        return false;
    }
    if (step == 3) {
        if (j != 0 || bx >= 64) return false;
        const int ci = bx >> 2, kind = ci >> 3, bb = (ci >> 2) & 1, hh = ci & 3; J.G = 4; J.c = bx & 3;
        const bf16* KVM = (const bf16*)(ws + WS_KVM);
        if (kind == 0) {
            J.g = pg8::Gemm{KVM + (size_t)(bb * NMEM) * 2048 + hh * 256, (const bf16*)(ws + WS_WMQN) + hh * 256, 256, DM, 256, 2048, DM};
            J.O = (bf16*)(ws + WS_WK) + (size_t)(bb * DM + hh * 256) * DM; J.ldc = DM;
        } else {
            J.g = pg8::Gemm{(const bf16*)(ws + WS_WMO) + hh * 256, KVM + (size_t)(bb * NMEM) * 2048 + DM + hh * 256, DM, 256, 256, DM, 2048};
            J.O = (bf16*)(ws + WS_VW) + (size_t)bb * DM * DM + hh * 256; J.ldc = DM;
        }
        return true;
    }
    if (step == 7 || step == 9) {
        if (j != 0) return false;
        const int half = (step == 9);
        J.g = pg8::Gemm{(const bf16*)(ws + WS_H), (const bf16*)(ws + WS_WUP) + (size_t)half * DFF * DM, M, DFF, DM, DM, DM}; J.O = (bf16*)(ws + WS_U); J.ldc = DFF; J.ps_in = (const float*)(ws + WS_PS); return true;
    }
    return false;
}
__device__ __forceinline__ bool f32_job(const Ctx& F, int step, Job& J) {
    unsigned char* ws = F.ws; const int bx = (int)blockIdx.x;
    J.G = F.G; J.c = bx; J.hn = nullptr; J.gn = nullptr; J.ps_out = nullptr;
    if (step == 4) { J.g = pg8::Gemm{(const bf16*)(ws + WS_AO), (const bf16*)(ws + WS_WOUT), M, DM, DM, DM, DM}; J.base = inp(F, 0); J.out = F.out; J.ldc = DM;
        J.hn = (bf16*)(ws + WS_H); J.gn = inp(F, 8); J.ps_out = (float*)(ws + WS_PS); return true; }
    if (step == 6) {
        const int bb = bx & 1; J.G = F.G >> 1; J.c = bx >> 1;
        if ((F.G & 1) && bx == F.G - 1) return false;
        J.g = pg8::Gemm{(const bf16*)(ws + WS_P) + (size_t)bb * SEQ * DM, (const bf16*)(ws + WS_VW) + (size_t)bb * DM * DM, SEQ, DM, DM, DM, DM}; J.out = F.out + (size_t)bb * SEQ * DM; J.base = J.out; J.ldc = DM;
        J.hn = (bf16*)(ws + WS_H) + (size_t)bb * SEQ * DM; J.gn = inp(F, 13); J.ps_out = (float*)(ws + WS_PS) + (size_t)bb * SEQ * 16; return true;
    }
    if (step == 11) { J.g = pg8::Gemm{(const bf16*)(ws + WS_ACT), (const bf16*)(ws + WS_WDOWN), M, DM, DFF, DFF, DFF}; J.base = F.out; J.out = F.out; J.ldc = DM; return true; }
    return false;
}

#define XB_TMO      128
#define XB_XCNT(j)  (256  + 64 * (j))
#define XB_XSUB(j)  (1280 + 64 * (j))
#define XB_XGEN(j)  (2304 + 64 * (j))
#define XB_TOP      3328
#define XB_TOPGEN   3392
#define XCD_BAR_WORDS 3456
#define XB_SPIN_CAP (1u << 18)

__device__ __forceinline__ unsigned xb_ld(unsigned* p)              { return __hip_atomic_load(p, __ATOMIC_RELAXED, __HIP_MEMORY_SCOPE_AGENT); }
__device__ __forceinline__ unsigned xb_add(unsigned* p, unsigned v) { return __hip_atomic_fetch_add(p, v, __ATOMIC_RELAXED, __HIP_MEMORY_SCOPE_AGENT); }
__device__ __forceinline__ unsigned xb_xcc_id() { return (unsigned)__builtin_amdgcn_s_getreg((3 << 11) | 20) & 0xFu; }
#define XB_SPIN(cond, bar) do { unsigned _sp = 0; while (cond) { __builtin_amdgcn_s_sleep(1); \
    if ((++_sp & 255u) == 0u) { if (xb_ld(&(bar)[XB_TMO])) break; if (_sp > XB_SPIN_CAP) { atomicAdd(&(bar)[XB_TMO], 1u); break; } } } } while (0)

struct XcdBarrier {
    unsigned* bar; unsigned x;
    volatile LAS unsigned* st;
};

__device__ __forceinline__ XcdBarrier xcd_barrier_post(unsigned* bar, volatile LAS unsigned* st) {
    XcdBarrier b; b.bar = bar; b.x = xb_xcc_id(); b.st = st;
    if (threadIdx.x == 0) (void)xb_add(&bar[XB_XCNT(b.x)], 1u);
    return b;
}
__device__ __forceinline__ void xcd_barrier_complete(unsigned* bar, unsigned x, unsigned& nloc, unsigned& nx) {
    const unsigned G = gridDim.x * gridDim.y * gridDim.z;
    unsigned sum, cnt, mine, sp = 0u;
    for (;;) {
        sum = 0u; cnt = 0u; mine = 0u;
#pragma unroll
        for (unsigned j = 0; j < 16; ++j) { const unsigned c = xb_ld(&bar[XB_XCNT(j)]); sum += c; cnt += (c > 0u) ? 1u : 0u; mine = (j == x) ? c : mine; }
        if (sum == G) break;
        __builtin_amdgcn_s_sleep(1);
        if ((++sp & 255u) == 0u) { if (xb_ld(&bar[XB_TMO])) break; if (sp > XB_SPIN_CAP) { atomicAdd(&bar[XB_TMO], 1u); break; } }
    }
    nloc = mine > 0u ? mine : 1u; nx = cnt > 0u ? cnt : 1u;
}

__device__ __forceinline__ void xcd_barrier(const XcdBarrier& b) {
    asm volatile("s_waitcnt vmcnt(0)" ::: "memory");
    __syncthreads();
    if (threadIdx.x == 0) {
        unsigned* bar = b.bar;
        __builtin_amdgcn_s_waitcnt(0);
        unsigned nloc = b.st[0], nx = b.st[1];
        if (nloc == 0u) { xcd_barrier_complete(bar, b.x, nloc, nx); b.st[0] = nloc; b.st[1] = nx; }
        const unsigned old = xb_add(&bar[XB_XSUB(b.x)], 1u);
        const unsigned gen = old / nloc;
        if (old + 1u == (gen + 1u) * nloc) {
            __builtin_amdgcn_fence(__ATOMIC_RELEASE, "agent");
            asm volatile("s_waitcnt vmcnt(0)" ::: "memory");
            const unsigned og = xb_add(&bar[XB_TOP], 1u);
            const unsigned tg = og / nx;
            if (og + 1u == (tg + 1u) * nx) xb_add(&bar[XB_TOPGEN], 1u);
            else XB_SPIN(xb_ld(&bar[XB_TOPGEN]) == tg, bar);
            __builtin_amdgcn_fence(__ATOMIC_ACQUIRE, "agent");
            xb_add(&bar[XB_XGEN(b.x)], 1u);
            asm volatile("s_waitcnt vmcnt(0)" ::: "memory");
        } else {
            XB_SPIN(xb_ld(&bar[XB_XGEN(b.x)]) == gen, bar);
            __builtin_amdgcn_fence(__ATOMIC_ACQUIRE, "agent");
            asm volatile("s_waitcnt vmcnt(0)" ::: "memory");
        }
    }
    __syncthreads();
}

__global__ void __launch_bounds__(NWAVES * 64, 2) fwd_kernel(Args args) {
    extern __shared__ __attribute__((aligned(16))) unsigned char lds[];
    cg::grid_group grid = cg::this_grid();
    Ctx F0;
    F0.lds = (LAS unsigned char*)lds; F0.tid = threadIdx.x; F0.lane = F0.tid & 63; F0.wave = __builtin_amdgcn_readfirstlane(F0.tid >> 6);
    F0.G = gridDim.x; { const int bx = blockIdx.x; F0.vcu = (F0.G % 8 == 0) ? (bx % 8) * (F0.G / 8) + bx / 8 : bx; }
    F0.out = args.out; F0.ws = args.ws;
    if (F0.tid == 0) { LAS unsigned long long* pl = (LAS unsigned long long*)(F0.lds + PARAM_OFF);
#pragma unroll
        for (int i = 0; i < 19; ++i) pl[i] = (unsigned long long)args.in[i]; }
    if (F0.tid < 2) ((LAS unsigned*)(F0.lds + PARAM_OFF + 256))[F0.tid] = 0u;
    __syncthreads();
    const int lo = args.ph_lo, hi = args.ph_hi;
    XcdBarrier bar = xcd_barrier_post((unsigned*)(args.ws + WS_BAR), (volatile LAS unsigned*)(F0.lds + PARAM_OFF + 256));
#pragma nounroll
    for (int si = lo; si < hi; ++si) {
#if defined(PROBE_REP)
        const int step = si <= PROBE_REP ? si : si - 1;
#else
        const int step = si;
#endif
        Ctx F = F0;
        asm volatile("" : "+v"(F.tid)); F.lane = F.tid & 63; F.wave = __builtin_amdgcn_readfirstlane(F.tid >> 6);
        asm volatile("" : "+s"(F.vcu), "+s"(F.G));
        F.ws = (unsigned char*)(GAS unsigned char*)F.ws; F.out = (float*)(GAS float*)F.out;
        switch (step) {
            case 0: step_prologue(F); break;
            case 1: step_scan(F); break;
            case 2: step_attention(F); break;
            case 3: step_mixnorm(F); break;
            case 8: step_conv(F, 0); break;
            case 10: step_conv(F, 1); break;
            case 12: step_final(F); break;
            default: break;
        }
        __syncthreads();
#pragma nounroll
        for (int j = 0; j < 3; ++j) {
            Job J;
            if (!bf16_job(F, step, j, J)) break;
            pg8::StaticOrder S; S.init(J.g.M, J.g.N, J.G, J.c);
            pg8::EpiBf16 E{J.O, J.ldc, J.ps_in};
            pg8::gemm_phase<pg8::EpiBf16, pg8::StaticOrder, PG8_ALIGN, PG8_SP2>(F.lds, J.g, S, E);
            __syncthreads();
        }
        {
            Job J;
            if (f32_job(F, step, J)) {
                pg8::StaticOrder S; S.init(J.g.M, J.g.N, J.G, J.c);
                pg8::EpiResF32 E{J.base, J.out, J.ldc, J.hn, J.gn, J.ps_out};
                pg8::gemm_phase<pg8::EpiResF32, pg8::StaticOrder, PG8_ALIGN, PG8_SP2>(F.lds, J.g, S, E);
                __syncthreads();
            }
        }
        if (step == 5 && (int)blockIdx.x < 2 * (F.G >> 1)) {
            const int bx = (int)blockIdx.x, bb = bx & 1;
            pg8::Gemm g{(const bf16*)(F.ws + WS_H) + (size_t)bb * SEQ * DM, (const bf16*)(F.ws + WS_WK) + (size_t)bb * DM * DM, SEQ, DM, DM, DM, DM};
            pg8::StaticOrder S; S.init(SEQ, DM, F.G >> 1, bx >> 1);
            pg8::EpiSoftmax E{(const float*)(F.ws + WS_PS) + (size_t)bb * SEQ * 16, (bf16*)(F.ws + WS_P) + (size_t)bb * SEQ * DM, DM};
            pg8::gemm_phase<pg8::EpiSoftmax, pg8::StaticOrder, false, PG8_SP2>(F.lds, g, S, E);
            __syncthreads();
        }
        if (si + 1 < hi) { if (hi > 1000) grid.sync(); else xcd_barrier(bar); }
#if defined(PROBE_SYNC)
        if (si == 0) { for (int q = 0; q < 20; ++q) xcd_barrier(bar); }
#endif
    }
}

#ifndef MK_PER_STEP
#define MK_PER_STEP 0
#endif
extern "C" void kernel_launch(void* const* d_in, const int* in_sizes, int n_in, void* d_out, int out_size, void* d_ws, size_t ws_size, hipStream_t stream) {
    static int grid = 0;
    if (grid == 0) {
        if (n_in != 19 || in_sizes[0] != M * DM || out_size != M * DM || ws_size < WS_END) { fprintf(stderr, "kernel_launch: unexpected shapes (n_in %d, in0 %d, out %d, ws %zu)\n", n_in, n_in > 0 ? in_sizes[0] : -1, out_size, ws_size); grid = -1; return; }
        int dev = 0, cus = 0, per_cu = 0;
        if (hipGetDevice(&dev) != hipSuccess || hipDeviceGetAttribute(&cus, hipDeviceAttributeMultiprocessorCount, dev) != hipSuccess) { grid = -1; return; }
        if (hipFuncSetAttribute((const void*)fwd_kernel, hipFuncAttributeMaxDynamicSharedMemorySize, LDS_BYTES) != hipSuccess) { fprintf(stderr, "kernel_launch: hipFuncSetAttribute failed\n"); grid = -1; return; }
        if (hipOccupancyMaxActiveBlocksPerMultiprocessor(&per_cu, (const void*)fwd_kernel, NWAVES * 64, LDS_BYTES) != hipSuccess || per_cu < 1) { fprintf(stderr, "kernel_launch: occupancy query says %d\n", per_cu); per_cu = 1; }
        (void)hipGetLastError();
        grid = cus;
    }
    if (grid < 0) return;
    Args a{};
    for (int i = 0; i < 19; ++i) a.in[i] = (const float*)d_in[i];
    a.out = (float*)d_out; a.ws = (unsigned char*)d_ws;
    if (hipMemsetAsync((char*)d_ws + WS_BAR, 0, BAR_ZERO_BYTES, stream) != hipSuccess) { fprintf(stderr, "kernel_launch: hipMemsetAsync failed\n"); return; }
#if MK_PER_STEP
    for (int s = 0; s < NSTEPS; ++s) { a.ph_lo = s; a.ph_hi = s + 1; hipLaunchKernelGGL(fwd_kernel, dim3(grid), dim3(NWAVES * 64), LDS_BYTES, stream, a); }
#else
#if defined(PROBE_REP)
    a.ph_lo = 0; a.ph_hi = NSTEPS + 1;
#else
    a.ph_lo = 0; a.ph_hi = NSTEPS;
#endif
    void* kargs[] = {&a};
    const hipError_t e = hipLaunchCooperativeKernel((const void*)fwd_kernel, dim3(grid), dim3(NWAVES * 64), kargs, LDS_BYTES, stream);
    if (e != hipSuccess) fprintf(stderr, "kernel_launch: cooperative launch failed: %s (grid %d)\n", hipGetErrorString(e), grid);
#endif
}
```
